# Optimizing an MI355X kernel written in HIP

```python
import math
import jax, jax.numpy as jnp
from jax import lax
import numpy as np

D_MODEL = 1024
BATCH = 4
SEQ = 4096
DEPTH = 1

MIX_WIDTH = D_MODEL
POOL_WIDTH = MIX_WIDTH // 2
POOL_WINDOWS = (2, 4, 8, 16)
N_POOL_GROUPS = len(POOL_WINDOWS)
POOL_GROUP_DIM = POOL_WIDTH // N_POOL_GROUPS
ATTN_WIDTH = MIX_WIDTH - POOL_WIDTH
HEAD_DIM = 64
N_ATTN_HEADS = ATTN_WIDTH // HEAD_DIM
DILATED_BRANCHES = ((128, 1), (512, 4), (2048, 16))
ATTN_BLOCK = 128
IN_WIDTH = POOL_WIDTH + 3 * ATTN_WIDTH
N_REL_BUCKETS = 32
REL_MAX_EXACT = N_REL_BUCKETS // 2
REL_MAX_DISTANCE = 2048
N_EXPERTS = 32
TOP_K = 4
D_EXPERT = D_MODEL
SWIGLU_LIMIT = 7.0
SWIGLU_ALPHA = 1.702
MOE_BLOCK = 128
PLE_DIM = 256
NORM_EPS = 1e-6
NEG_INF = -1e30

kernel_name = "hybrid_pool_dilated_attn_moe_ple"


def rmsnorm(x, g):
    xf = x.astype(jnp.float32)
    y = xf * lax.rsqrt(jnp.mean(xf * xf, axis=-1, keepdims=True) + NORM_EPS)
    return (y * g.astype(jnp.float32)).astype(x.dtype)


def pool_mixer(u, w_pool, pool_scale):
    B, S, _ = u.shape
    ug = u.reshape(B, S, N_POOL_GROUPS, POOL_GROUP_DIM)
    t = jnp.arange(S)
    outs = []
    for gi, w in enumerate(POOL_WINDOWS):
        ch = ug[:, :, gi].astype(jnp.float32)
        cs = jnp.cumsum(ch, axis=1)
        prev = jnp.pad(cs, ((0, 0), (w, 0), (0, 0)))[:, :S]
        cnt = jnp.minimum(t + 1, w).astype(jnp.float32)[None, :, None]
        outs.append(((cs - prev) / cnt - ch).astype(u.dtype))
    pooled = jnp.stack(outs, axis=2)
    mixed = jnp.einsum('bsgc,gcd->bsgd', pooled, w_pool)
    return mixed.reshape(B, S, POOL_WIDTH) * pool_scale


def t5_bucket(dist):
    n = jnp.maximum(dist, 1).astype(jnp.float32)
    large = REL_MAX_EXACT + (jnp.log(n / REL_MAX_EXACT) / math.log(REL_MAX_DISTANCE / REL_MAX_EXACT)
                             * (N_REL_BUCKETS - REL_MAX_EXACT)).astype(jnp.int32)
    large = jnp.minimum(large, N_REL_BUCKETS - 1)
    return jnp.where(dist < REL_MAX_EXACT, dist, large)


def dilated_branch(q, k, v, rel_bias, window, dil):
    B, S, H, Dh = q.shape
    w_sub = window // dil
    blk = ATTN_BLOCK
    span = dil * blk
    Sp = -(-S // span) * span
    L = Sp // dil
    nb = L // blk

    def to_sub(t):
        t = jnp.pad(t, ((0, 0), (0, Sp - S), (0, 0), (0, 0)))
        t = t.reshape(B, nb, blk, dil, H, Dh)
        return t.transpose(0, 3, 4, 1, 2, 5)

    qs, ks, vs = to_sub(q), to_sub(k), to_sub(v)
    shift = lambda t: jnp.concatenate([jnp.zeros_like(t[:, :, :, :1]), t[:, :, :, :-1]], axis=3)
    keys = jnp.concatenate([shift(ks), ks], axis=4)
    vals = jnp.concatenate([shift(vs), vs], axis=4)

    s = jnp.einsum('brhnqc,brhnkc->brhnqk', qs, keys).astype(jnp.float32) * (1.0 / math.sqrt(Dh))
    qi = jnp.arange(blk)[:, None]
    ki = jnp.arange(2 * blk)[None, :]
    rel = blk + qi - ki
    bias = rel_bias[t5_bucket(jnp.maximum(rel, 0) * dil)]
    s = s + bias.transpose(2, 0, 1)[:, None].astype(jnp.float32)
    band = (rel >= 0) & (rel <= w_sub)
    first_ok = (jnp.arange(nb)[:, None, None] > 0) | (ki[None] >= blk)
    mask = band[None] & first_ok
    s = jnp.where(mask, s, NEG_INF)
    m = jnp.max(s, axis=-1)
    e = jnp.exp(s - m[..., None])
    l = jnp.sum(e, axis=-1)
    o = jnp.einsum('brhnqk,brhnkc->brhnqc', e, vals.astype(jnp.float32)) / l[..., None]
    lse = m + jnp.log(l)
    o = o.transpose(0, 3, 4, 1, 2, 5).reshape(B, Sp, H, Dh)[:, :S]
    lse = lse.transpose(0, 3, 4, 1, 2).reshape(B, Sp, H)[:, :S]
    return o, lse


def dilated_attention(q, k, v, rel_bias):
    outs, lses = [], []
    for window, dil in DILATED_BRANCHES:
        o, lse = dilated_branch(q, k, v, rel_bias, window, dil)
        outs.append(o)
        lses.append(lse)
    w = jax.nn.softmax(jnp.stack(lses, axis=0), axis=0)
    out = jnp.sum(w[..., None] * jnp.stack(outs, axis=0), axis=0)
    return out.astype(q.dtype)


def moe(h, w_router, b_router, w_gate_up, b_gate_up, w_down, b_down):
    B, S, D = h.shape
    T = B * S
    hf = h.reshape(T, D)
    logits = (hf @ w_router + b_router).astype(jnp.float32)
    topv, topi = lax.top_k(logits, TOP_K)
    gates = jax.nn.softmax(topv, axis=-1)

    expert_ids = topi.reshape(-1)
    token_ids = jnp.repeat(jnp.arange(T), TOP_K)
    gate_flat = gates.reshape(-1)
    order = jnp.argsort(expert_ids)
    sorted_e = expert_ids[order]
    group_sizes = jnp.bincount(expert_ids, length=N_EXPERTS)
    group_starts = jnp.cumsum(group_sizes) - group_sizes
    padded_sizes = (group_sizes + MOE_BLOCK - 1) // MOE_BLOCK * MOE_BLOCK
    padded_ends = jnp.cumsum(padded_sizes)
    padded_starts = padded_ends - padded_sizes
    rank = jnp.arange(T * TOP_K) - group_starts[sorted_e]
    dest = padded_starts[sorted_e] + rank

    n_rows = T * TOP_K + N_EXPERTS * MOE_BLOCK
    n_blocks = n_rows // MOE_BLOCK
    row_token = jnp.zeros((n_rows,), jnp.int32).at[dest].set(token_ids[order])
    row_gate = jnp.zeros((n_rows,), h.dtype).at[dest].set(gate_flat[order].astype(h.dtype))
    block_expert = jnp.minimum(
        jnp.searchsorted(padded_ends, jnp.arange(n_blocks) * MOE_BLOCK, side='right'),
        N_EXPERTS - 1)
    xs = hf[row_token].reshape(n_blocks, MOE_BLOCK, D)

    def expert_block(args):
        xb, e = args
        gu = xb @ w_gate_up[e] + b_gate_up[e]
        g, u = gu[:, :D_EXPERT], gu[:, D_EXPERT:]
        g = jnp.minimum(g, SWIGLU_LIMIT)
        u = jnp.clip(u, -SWIGLU_LIMIT, SWIGLU_LIMIT)
        glu = g * jax.nn.sigmoid(SWIGLU_ALPHA * g)
        return ((u + 1.0) * glu) @ w_down[e] + b_down[e]

    ys = lax.map(expert_block, (xs, block_expert)).reshape(n_rows, D)
    out = jnp.zeros((T, D), h.dtype).at[row_token].add(ys * row_gate[:, None])
    return out.reshape(B, S, D)


def setup_inputs(seed: int = 0) -> dict:
    key = jax.random.key(seed)
    ks = jax.random.split(key, 24)
    f32 = jnp.float32
    nrm = lambda k, shape, s: jax.random.normal(k, shape, f32) * s
    gain = lambda k, shape: 1.0 + 0.05 * jax.random.normal(k, shape, f32)
    return {
        "x": nrm(ks[0], (BATCH, SEQ, D_MODEL), 1.0),
        "p": nrm(ks[1], (DEPTH, BATCH, SEQ, PLE_DIM), 1.0),
        "g_mix": gain(ks[2], (DEPTH, D_MODEL)),
        "w_in": nrm(ks[3], (DEPTH, D_MODEL, IN_WIDTH), D_MODEL ** -0.5),
        "w_pool": nrm(ks[4], (DEPTH, N_POOL_GROUPS, POOL_GROUP_DIM, POOL_GROUP_DIM), POOL_GROUP_DIM ** -0.5),
        "pool_scale": gain(ks[5], (DEPTH, POOL_WIDTH)),
        "rel_bias": nrm(ks[6], (N_REL_BUCKETS, N_ATTN_HEADS), 0.5),
        "w_out": nrm(ks[7], (DEPTH, MIX_WIDTH, D_MODEL), MIX_WIDTH ** -0.5),
        "g_ffn": gain(ks[8], (DEPTH, D_MODEL)),
        "w_router": nrm(ks[9], (DEPTH, D_MODEL, N_EXPERTS), D_MODEL ** -0.5),
        "b_router": nrm(ks[10], (DEPTH, N_EXPERTS), 0.01),
        "w_gate_up": nrm(ks[11], (DEPTH, N_EXPERTS, D_MODEL, 2 * D_EXPERT), D_MODEL ** -0.5),
        "b_gate_up": nrm(ks[12], (DEPTH, N_EXPERTS, 2 * D_EXPERT), 0.01),
        "w_down": nrm(ks[13], (DEPTH, N_EXPERTS, D_EXPERT, D_MODEL), D_EXPERT ** -0.5),
        "b_down": nrm(ks[14], (DEPTH, N_EXPERTS, D_MODEL), 0.01),
        "g_ple": gain(ks[15], (DEPTH, D_MODEL)),
        "w_ple_gate": nrm(ks[16], (DEPTH, D_MODEL, D_MODEL), D_MODEL ** -0.5),
        "w_ple_proj": nrm(ks[17], (DEPTH, PLE_DIM, D_MODEL), PLE_DIM ** -0.5),
        "g_final": gain(ks[18], (D_MODEL,)),
    }


def reference(x, p, g_mix, w_in, w_pool, pool_scale, rel_bias, w_out, g_ffn,
              w_router, b_router, w_gate_up, b_gate_up, w_down, b_down,
              g_ple, w_ple_gate, w_ple_proj, g_final):
    B, S, _ = x.shape
    for i in range(DEPTH):
        h = rmsnorm(x, g_mix[i])
        z = jnp.einsum('bsd,de->bse', h, w_in[i])
        u = z[..., :POOL_WIDTH]
        qkv = z[..., POOL_WIDTH:].reshape(B, S, 3, N_ATTN_HEADS, HEAD_DIM)
        q, k, v = qkv[:, :, 0], qkv[:, :, 1], qkv[:, :, 2]
        a_out = pool_mixer(u, w_pool[i], pool_scale[i])
        b_out = dilated_attention(q, k, v, rel_bias).reshape(B, S, ATTN_WIDTH)
        mix = jnp.concatenate([a_out, b_out], axis=-1)
        x = x + jnp.einsum('bse,ed->bsd', mix, w_out[i])
        x = x + moe(rmsnorm(x, g_ffn[i]), w_router[i], b_router[i], w_gate_up[i],
                    b_gate_up[i], w_down[i], b_down[i])
        gate = jax.nn.sigmoid(jnp.einsum('bsd,de->bse', rmsnorm(x, g_ple[i]), w_ple_gate[i]))
        x = x + jnp.einsum('bsp,pd->bsd', p[i], w_ple_proj[i]) * gate
    return rmsnorm(x, g_final)
```

```cpp
#include <hip/hip_runtime.h>
#include <cstdio>
#include <cstdint>
#include <cmath>
namespace nv {
constexpr int T = 16384, D = 1024, S = 4096, INW = 2048, PW = 512, AW = 512, NH = 8, HD = 64, NE = 32, DE = 1024, PLE = 256;
constexpr float EPS = 1e-6f;

__global__ void __launch_bounds__(256) k_rmsnorm(const float* __restrict__ x, const float* __restrict__ g, float* __restrict__ out) {
    __shared__ float red[4];
    const int row = blockIdx.x, tid = threadIdx.x;
    const float4 v = ((const float4*)(x + (size_t)row * D))[tid];
    float s = v.x * v.x + v.y * v.y + v.z * v.z + v.w * v.w;
    for (int o = 32; o > 0; o >>= 1) s += __shfl_xor(s, o);
    if ((tid & 63) == 0) red[tid >> 6] = s;
    __syncthreads();
    s = red[0] + red[1] + red[2] + red[3];
    const float r = 1.0f / sqrtf(s * (1.0f / D) + EPS);
    const float4 gg = ((const float4*)g)[tid];
    float4 o4; o4.x = v.x * r * gg.x; o4.y = v.y * r * gg.y; o4.z = v.z * r * gg.z; o4.w = v.w * r * gg.w;
    ((float4*)(out + (size_t)row * D))[tid] = o4;
}

struct GemmArgs {
    const float* A; const int* arow; int lda;
    const float* B; int ldb;
    float* C; const int* crow; int ldc;
    const float* bias; const float* rscale;
    const int* Mptr; int M, N, K; int atomic;
};
__global__ void __launch_bounds__(256) k_gemm(GemmArgs a) {
    __shared__ float As[16][68];
    __shared__ float Bs[16][68];
    const int M = a.Mptr ? *a.Mptr : a.M;
    const int m0 = blockIdx.y * 64, n0 = blockIdx.x * 64;
    if (m0 >= M) return;
    const int tid = threadIdx.x, tx = tid & 15, ty = tid >> 4;
    float acc[4][4];
#pragma unroll
    for (int i = 0; i < 4; ++i)
#pragma unroll
        for (int j = 0; j < 4; ++j) acc[i][j] = 0.f;
    const int ar = tid >> 2, ak = (tid & 3) * 4;
    int arow_g = m0 + ar; const bool avalid = arow_g < M;
    if (avalid && a.arow) arow_g = a.arow[arow_g];
    const float* Ap = a.A + (size_t)(avalid ? arow_g : 0) * a.lda + ak;
    const int bk = tid >> 4, bn = (tid & 15) * 4;
    const float* Bp = a.B + (size_t)bk * a.ldb + n0 + bn;
    for (int k0 = 0; k0 < a.K; k0 += 16) {
        float4 av = avalid ? *(const float4*)(Ap + k0) : make_float4(0.f, 0.f, 0.f, 0.f);
        float4 bv = *(const float4*)(Bp + (size_t)k0 * a.ldb);
        As[ak + 0][ar] = av.x; As[ak + 1][ar] = av.y; As[ak + 2][ar] = av.z; As[ak + 3][ar] = av.w;
        *(float4*)&Bs[bk][bn] = bv;
        __syncthreads();
#pragma unroll
        for (int k = 0; k < 16; ++k) {
            const float4 a4 = *(const float4*)&As[k][ty * 4];
            const float4 b4 = *(const float4*)&Bs[k][tx * 4];
            const float aa[4] = {a4.x, a4.y, a4.z, a4.w}, bb[4] = {b4.x, b4.y, b4.z, b4.w};
#pragma unroll
            for (int i = 0; i < 4; ++i)
#pragma unroll
                for (int j = 0; j < 4; ++j) acc[i][j] = fmaf(aa[i], bb[j], acc[i][j]);
        }
        __syncthreads();
    }
#pragma unroll
    for (int i = 0; i < 4; ++i) {
        const int m = m0 + ty * 4 + i;
        if (m >= M) continue;
        const int cr = a.crow ? a.crow[m] : m;
        const float rs = a.rscale ? a.rscale[m] : 1.0f;
#pragma unroll
        for (int j = 0; j < 4; ++j) {
            const int n = n0 + tx * 4 + j;
            float v = acc[i][j] + (a.bias ? a.bias[n] : 0.f);
            v *= rs;
            float* cp = a.C + (size_t)cr * a.ldc + n;
            if (a.atomic) atomicAdd(cp, v); else *cp = v;
        }
    }
}

__global__ void __launch_bounds__(256) k_pool(const float* __restrict__ z, float* __restrict__ pooled) {
    const int idx = blockIdx.x * 256 + threadIdx.x;
    const int tg = idx >> 9, c = idx & 511;
    const int t = tg & (S - 1);
    const int w = 2 << (c >> 7);
    const int cnt = (t + 1 < w) ? t + 1 : w;
    float s = 0.f;
    for (int j = 0; j < cnt; ++j) s += z[(size_t)(tg - j) * INW + c];
    pooled[idx] = s / (float)cnt - z[(size_t)tg * INW + c];
}
__global__ void __launch_bounds__(256) k_poolmix(const float* __restrict__ pooled, const float* __restrict__ wp, const float* __restrict__ scale, float* __restrict__ mix) {
    const int idx = blockIdx.x * 256 + threadIdx.x;
    const int tg = idx >> 9, c = idx & 511, g = c >> 7, d = c & 127;
    const float* pr = pooled + (size_t)tg * 512 + g * 128;
    const float* w = wp + (size_t)g * 128 * 128 + d;
    float s = 0.f;
    for (int k = 0; k < 128; ++k) s = fmaf(pr[k], w[(size_t)k * 128], s);
    mix[(size_t)tg * 1024 + c] = s * scale[c];
}

__device__ __forceinline__ int t5_bucket(int dist) {
    if (dist < 16) return dist;
    const float n = (float)dist;
    int large = 16 + (int)(logf(n / 16.0f) / logf(128.0f) * 16.0f);
    return large < 31 ? large : 31;
}
__global__ void __launch_bounds__(256) k_attn(const float* __restrict__ z, const float* __restrict__ rel_bias, float* __restrict__ mix) {
    const int idx = blockIdx.x * 4 + (threadIdx.x >> 6);
    const int lane = threadIdx.x & 63;
    const int tg = idx >> 3, h = idx & 7, t = tg & (S - 1);
    const float q = z[(size_t)tg * INW + 512 + h * 64 + lane];
    float o0 = 0.f, o1 = 0.f, o2 = 0.f, l0 = 0.f, l1 = 0.f, l2 = 0.f;
    for (int br = 0; br < 3; ++br) {
        const int dil = br == 0 ? 1 : (br == 1 ? 4 : 16);
        const int l = t / dil;
        const int nkeys = l < 128 ? l + 1 : 129;
        float m = -1e30f, lsum = 0.f, o = 0.f;
        for (int rel = 0; rel < nkeys; ++rel) {
            const size_t kr = (size_t)(tg - rel * dil) * INW;
            float s = q * z[kr + 1024 + h * 64 + lane];
            for (int sh = 32; sh > 0; sh >>= 1) s += __shfl_xor(s, sh);
            s = s * 0.125f + rel_bias[t5_bucket(rel * dil) * 8 + h];
            const float mn = fmaxf(m, s), f = expf(m - mn), pe = expf(s - mn);
            lsum = lsum * f + pe;
            o = o * f + pe * z[kr + 1536 + h * 64 + lane];
            m = mn;
        }
        const float ob = o / lsum, ls = m + logf(lsum);
        if (br == 0) { o0 = ob; l0 = ls; } else if (br == 1) { o1 = ob; l1 = ls; } else { o2 = ob; l2 = ls; }
    }
    const float mm = fmaxf(l0, fmaxf(l1, l2));
    const float w0 = expf(l0 - mm), w1 = expf(l1 - mm), w2 = expf(l2 - mm), ws = 1.0f / (w0 + w1 + w2);
    mix[(size_t)tg * 1024 + 512 + h * 64 + lane] = (w0 * o0 + w1 * o1 + w2 * o2) * ws;
}

__global__ void __launch_bounds__(256) k_add(const float* __restrict__ a, const float* __restrict__ b, float* __restrict__ o, size_t n4) {
    const size_t i = (size_t)blockIdx.x * 256 + threadIdx.x;
    if (i >= n4) return;
    const float4 x = ((const float4*)a)[i], y = ((const float4*)b)[i];
    ((float4*)o)[i] = make_float4(x.x + y.x, x.y + y.y, x.z + y.z, x.w + y.w);
}
__global__ void __launch_bounds__(256) k_copy(const float* __restrict__ a, float* __restrict__ o, size_t n4) {
    const size_t i = (size_t)blockIdx.x * 256 + threadIdx.x;
    if (i < n4) ((float4*)o)[i] = ((const float4*)a)[i];
}
__global__ void __launch_bounds__(64) k_zero_cnt(int* cnt) { if (threadIdx.x < 64) cnt[threadIdx.x] = 0; }

__global__ void __launch_bounds__(256) k_router(const float* __restrict__ xn, const float* __restrict__ wr, const float* __restrict__ br,
                                                int* __restrict__ cnt, int* __restrict__ list_tok, float* __restrict__ list_gate) {
    __shared__ float lg[32];
    const int t = blockIdx.x, tid = threadIdx.x, e = tid >> 3, part = tid & 7;
    const float* xr = xn + (size_t)t * D;
    float s = 0.f;
    for (int k = part; k < D; k += 8) s = fmaf(xr[k], wr[(size_t)k * NE + e], s);
    s += __shfl_xor(s, 1); s += __shfl_xor(s, 2); s += __shfl_xor(s, 4);
    if (part == 0) lg[e] = s + br[e];
    __syncthreads();
    if (tid == 0) {
        int ti0 = 0, ti1 = 0, ti2 = 0, ti3 = 0; float tv0 = 0.f, tv1 = 0.f, tv2 = 0.f, tv3 = 0.f;
        for (int k = 0; k < 4; ++k) {
            int bi = 0; float bv = -INFINITY;
            for (int i = 0; i < 32; ++i) { const float vv = lg[i]; if (vv > bv) { bv = vv; bi = i; } }
            lg[bi] = -INFINITY;
            if (k == 0) { ti0 = bi; tv0 = bv; } else if (k == 1) { ti1 = bi; tv1 = bv; } else if (k == 2) { ti2 = bi; tv2 = bv; } else { ti3 = bi; tv3 = bv; }
        }
        const float e0 = 1.0f, e1 = expf(tv1 - tv0), e2 = expf(tv2 - tv0), e3 = expf(tv3 - tv0), inv = 1.0f / (e0 + e1 + e2 + e3);
        int pos;
        pos = atomicAdd(&cnt[ti0], 1); list_tok[(size_t)ti0 * T + pos] = t; list_gate[(size_t)ti0 * T + pos] = e0 * inv;
        pos = atomicAdd(&cnt[ti1], 1); list_tok[(size_t)ti1 * T + pos] = t; list_gate[(size_t)ti1 * T + pos] = e1 * inv;
        pos = atomicAdd(&cnt[ti2], 1); list_tok[(size_t)ti2 * T + pos] = t; list_gate[(size_t)ti2 * T + pos] = e2 * inv;
        pos = atomicAdd(&cnt[ti3], 1); list_tok[(size_t)ti3 * T + pos] = t; list_gate[(size_t)ti3 * T + pos] = e3 * inv;
    }
}
__global__ void __launch_bounds__(256) k_swiglu(const float* __restrict__ gu, float* __restrict__ hid, const int* __restrict__ Mptr) {
    const int m = blockIdx.x; if (m >= *Mptr) return;
    for (int j = threadIdx.x; j < DE; j += 256) {
        float g = gu[(size_t)m * 2048 + j], u = gu[(size_t)m * 2048 + 1024 + j];
        g = fminf(g, 7.0f); u = fminf(fmaxf(u, -7.0f), 7.0f);
        const float glu = g / (1.0f + expf(-1.702f * g));
        hid[(size_t)m * DE + j] = (u + 1.0f) * glu;
    }
}
__global__ void __launch_bounds__(256) k_ple(const float* __restrict__ x2, const float* __restrict__ pp, const float* __restrict__ gl, float* __restrict__ o, size_t n) {
    const size_t i = (size_t)blockIdx.x * 256 + threadIdx.x;
    if (i < n) o[i] = x2[i] + pp[i] / (1.0f + expf(-gl[i]));
}

static void gemm(hipStream_t st, const float* A, const int* arow, int lda, const float* B, int ldb, float* C, const int* crow, int ldc,
                 const float* bias, const float* rscale, const int* Mptr, int M, int N, int K, int atomic) {
    GemmArgs a{}; a.A = A; a.arow = arow; a.lda = lda; a.B = B; a.ldb = ldb; a.C = C; a.crow = crow; a.ldc = ldc; a.bias = bias; a.rscale = rscale;
    a.Mptr = Mptr; a.M = M; a.N = N; a.K = K; a.atomic = atomic;
    hipLaunchKernelGGL(k_gemm, dim3(N / 64, (M + 63) / 64), dim3(256), 0, st, a);
}

static void forward(void* const* d_in, void* d_out, void* d_ws, hipStream_t st) {
    const float* x = (const float*)d_in[0]; const float* p = (const float*)d_in[1]; const float* g_mix = (const float*)d_in[2];
    const float* w_in = (const float*)d_in[3]; const float* w_pool = (const float*)d_in[4]; const float* pool_scale = (const float*)d_in[5];
    const float* rel_bias = (const float*)d_in[6]; const float* w_out = (const float*)d_in[7]; const float* g_ffn = (const float*)d_in[8];
    const float* w_router = (const float*)d_in[9]; const float* b_router = (const float*)d_in[10]; const float* w_gu = (const float*)d_in[11];
    const float* b_gu = (const float*)d_in[12]; const float* w_dn = (const float*)d_in[13]; const float* b_dn = (const float*)d_in[14];
    const float* g_ple = (const float*)d_in[15]; const float* w_pg = (const float*)d_in[16]; const float* w_pp = (const float*)d_in[17];
    const float* g_final = (const float*)d_in[18];
    float* out = (float*)d_out;
    char* ws = (char*)d_ws;
    const size_t MB = 1u << 20;
    float* xn = (float*)(ws + 0 * MB);
    float* z = (float*)(ws + 64 * MB);
    float* mix = (float*)(ws + 192 * MB);
    float* pooled = (float*)(ws + 256 * MB);
    float* x1 = (float*)(ws + 288 * MB);
    float* x2 = (float*)(ws + 352 * MB);
    float* tmp = (float*)(ws + 416 * MB);
    float* tmp2 = (float*)(ws + 480 * MB);
    int* list_tok = (int*)(ws + 544 * MB);
    float* list_gate = (float*)(ws + 546 * MB);
    int* cnt = (int*)(ws + 548 * MB);
    const size_t n4 = (size_t)T * D / 4;
    hipLaunchKernelGGL(k_rmsnorm, dim3(T), dim3(256), 0, st, x, g_mix, xn);
    gemm(st, xn, nullptr, D, w_in, INW, z, nullptr, INW, nullptr, nullptr, nullptr, T, INW, D, 0);
    hipLaunchKernelGGL(k_pool, dim3(T * 512 / 256), dim3(256), 0, st, z, pooled);
    hipLaunchKernelGGL(k_poolmix, dim3(T * 512 / 256), dim3(256), 0, st, pooled, w_pool, pool_scale, mix);
    hipLaunchKernelGGL(k_attn, dim3(T * 8 / 4), dim3(256), 0, st, z, rel_bias, mix);
    gemm(st, mix, nullptr, D, w_out, D, tmp, nullptr, D, nullptr, nullptr, nullptr, T, D, D, 0);
    hipLaunchKernelGGL(k_add, dim3((unsigned)(n4 / 256)), dim3(256), 0, st, x, tmp, x1, n4);
    hipLaunchKernelGGL(k_rmsnorm, dim3(T), dim3(256), 0, st, x1, g_ffn, xn);
    hipLaunchKernelGGL(k_zero_cnt, dim3(1), dim3(64), 0, st, cnt);
    hipLaunchKernelGGL(k_router, dim3(T), dim3(256), 0, st, xn, w_router, b_router, cnt, list_tok, list_gate);
    hipLaunchKernelGGL(k_copy, dim3((unsigned)(n4 / 256)), dim3(256), 0, st, x1, x2, n4);
    float* GU = z; float* HID = mix;
    for (int e = 0; e < NE; ++e) {
        gemm(st, xn, list_tok + (size_t)e * T, D, w_gu + (size_t)e * D * 2048, 2048, GU, nullptr, 2048, b_gu + (size_t)e * 2048, nullptr, cnt + e, T, 2048, D, 0);
        hipLaunchKernelGGL(k_swiglu, dim3(T), dim3(256), 0, st, GU, HID, cnt + e);
        gemm(st, HID, nullptr, DE, w_dn + (size_t)e * DE * D, D, x2, list_tok + (size_t)e * T, D, b_dn + (size_t)e * D, list_gate + (size_t)e * T, cnt + e, T, D, DE, 1);
    }
    hipLaunchKernelGGL(k_rmsnorm, dim3(T), dim3(256), 0, st, x2, g_ple, xn);
    gemm(st, xn, nullptr, D, w_pg, D, tmp, nullptr, D, nullptr, nullptr, nullptr, T, D, D, 0);
    gemm(st, p, nullptr, PLE, w_pp, D, tmp2, nullptr, D, nullptr, nullptr, nullptr, T, D, PLE, 0);
    hipLaunchKernelGGL(k_ple, dim3((unsigned)((size_t)T * D / 256)), dim3(256), 0, st, x2, tmp2, tmp, x1, (size_t)T * D);
    hipLaunchKernelGGL(k_rmsnorm, dim3(T), dim3(256), 0, st, x1, g_final, out);
}
}
extern "C" void kernel_launch(void* const* d_in, const int* in_sizes, int n_in, void* d_out, int out_size, void* d_ws, size_t ws_size, hipStream_t stream) {
    nv::forward(d_in, d_out, d_ws, stream);
}
```

```cpp
#include <hip/hip_runtime.h>
#include <cstdio>
#include <cstdint>
#include <cmath>
#define LAS __attribute__((address_space(3)))
#define GAS __attribute__((address_space(1)))
typedef unsigned short bf16_t;
typedef short bf16x8 __attribute__((ext_vector_type(8)));
typedef short s16x4 __attribute__((ext_vector_type(4)));
typedef float f32x4 __attribute__((ext_vector_type(4)));
typedef float f32x16 __attribute__((ext_vector_type(16)));
typedef float f32x2 __attribute__((ext_vector_type(2)));
typedef unsigned u32x4 __attribute__((ext_vector_type(4)));
typedef unsigned u32x2 __attribute__((ext_vector_type(2)));

namespace mk {
constexpr int T = 16384, D = 1024, S = 4096, NE = 32, PLE = 256;
constexpr int NROWS_MAX = 73728;
constexpr float EPS = 1e-6f;
constexpr float LOG2E = 1.4426950408889634f;
constexpr float QSCALE = 0.125f * LOG2E;

__device__ __forceinline__ unsigned cvt_pk_bf16(float lo, float hi) { unsigned r; asm volatile("v_cvt_pk_bf16_f32 %0, %1, %2" : "=v"(r) : "v"(lo), "v"(hi)); return r; }
__device__ __forceinline__ float bf2f(unsigned short b) { return __uint_as_float(((unsigned)b) << 16); }
__device__ __forceinline__ float bflo(unsigned w) { return __uint_as_float(w << 16); }
__device__ __forceinline__ float bfhi(unsigned w) { return __uint_as_float(w & 0xffff0000u); }
__device__ __forceinline__ float wave_sum(float v) {
#pragma unroll
    for (int o = 1; o < 64; o <<= 1) v += __shfl_xor(v, o);
    return v;
}
__device__ __forceinline__ float sigmoidf_fast(float z) { return __builtin_amdgcn_rcpf(1.0f + __builtin_amdgcn_exp2f(-LOG2E * z)); }

constexpr int BM = 256, BK = 64, HALF = 128, HTB = HALF * BK * 2, STAGE_BYTES = 8 * HTB, NXCD = 8, WGM = 8;
__host__ __device__ __forceinline__ int lds_byte(int r, int c) { const int st = (r >> 4) * 2 + (c >> 5), rr = r & 15, cc = c & 31, ob = rr * 64 + cc * 2; return st * 1024 + (ob ^ (((ob >> 9) & 1) << 5)); }
__host__ __device__ __forceinline__ void stage_rc(int b, int& R, int& C) { const int st = b / 1024, sb = b % 1024, swz = sb ^ (((sb >> 9) & 1) << 5); R = (st >> 1) * 16 + swz / 64; C = (st & 1) * 32 + (swz % 64) / 2; }
__host__ __device__ __forceinline__ int perm32(int rho) { const int n = rho >> 4, i = rho & 15; return 8 * (i >> 2) + 4 * n + (i & 3); }

struct Unit { int pm, pn; };
struct Gemm { const bf16_t* A; const bf16_t* Bt; int K; };

struct Order {
    int nM, nN, nwg, G, c; const LAS int* tile_e;
    __device__ __forceinline__ void init(int nM_, int nN_, int G_, int c_, const LAS int* te) { nM = nM_; nN = nN_; nwg = nM * nN; G = G_; c = c_; tile_e = te; }
    __device__ __forceinline__ bool next(int i, Unit& u) const {
        const long L = (long)i * G + c; if (L >= nwg) return false;
        int wgid = (int)L; { const int q = nwg / NXCD, r = nwg % NXCD, xcd = wgid % NXCD, off = wgid / NXCD; wgid = (xcd < r ? xcd * (q + 1) : r * (q + 1) + (xcd - r) * q) + off; }
        const int nig = WGM * nN, gid = wgid / nig, fm = gid * WGM, gsz = (nM - fm) < WGM ? (nM - fm) : WGM;
        u.pm = fm + ((wgid % nig) % gsz); u.pn = (wgid % nig) / gsz; return true;
    }
    __device__ __forceinline__ int b_tile(const Unit& u) const { return tile_e ? tile_e[u.pm] * nN + u.pn : u.pn; }
    __device__ __forceinline__ int expert(const Unit& u) const { return tile_e ? tile_e[u.pm] : 0; }
};

typedef f32x4 Acc[2][2][4][2];

template <class Epi, bool GATHER>
__device__ __forceinline__ void gemm_phase(LAS unsigned char* lds, const Gemm g, const Order& S, const Epi& E, const LAS int* gtab) {
    const int tid = threadIdx.x, wid = __builtin_amdgcn_readfirstlane(tid >> 6), lane = tid & 63, wr = wid >> 2, wc = wid & 3, fr = lane & 15, fq = lane >> 4;
    const int K = g.K, nt = K / BK;
    unsigned voffB[2], vA0[2], vA1[2]; int Rr[2], Cc[2];
#pragma unroll
    for (int i = 0; i < 2; ++i) { int R, C; stage_rc(tid * 16 + i * 8192, R, C); const int Rb = Epi::PERM ? ((R & ~31) + perm32(R & 31)) : R;
        Rr[i] = R; Cc[i] = C; voffB[i] = (unsigned)(Rb * K + C) * 2u;
        if constexpr (!GATHER) { vA0[i] = (unsigned)(R * K + C) * 2u; vA1[i] = vA0[i]; } }
    const size_t kstep = (size_t)(BK * 2);
    const size_t hstep = (size_t)HALF * K * 2;
    const size_t hstepA = GATHER ? 0 : hstep;
    const size_t tstep = 2 * hstep;
    const unsigned ldsw = (unsigned)wid * 1024u;
    const int aoff = lds_byte(wr * 64 + fr, fq * 8), boff = lds_byte(wc * 32 + fr, fq * 8);
#define PG8_SA(b, h) (((b) * 2 + (h)) * HTB)
#define PG8_SB(b, h) ((4 + (b) * 2 + (h)) * HTB)
#define PG8_STAGE(bufoff, gbase, voff) do { _Pragma("unroll") for (int _i = 0; _i < 2; ++_i) \
        __builtin_amdgcn_global_load_lds((const unsigned*)((const char*)(gbase) + (voff)[_i]), (LAS unsigned*)(lds + (bufoff) + ldsw + _i * 8192), 16, 0, 0); } while (0)
#define PG8_LDA(dst, b, h) do { _Pragma("unroll") for (int m = 0; m < 4; ++m) _Pragma("unroll") for (int k = 0; k < 2; ++k) dst[m][k] = *(const LAS bf16x8*)(lds + PG8_SA(b, h) + aoff + m * 2048 + k * 1024); } while (0)
#define PG8_LDB(dst, b, h) do { _Pragma("unroll") for (int n = 0; n < 2; ++n) _Pragma("unroll") for (int k = 0; k < 2; ++k) dst[n][k] = *(const LAS bf16x8*)(lds + PG8_SB(b, h) + boff + n * 2048 + k * 1024); } while (0)
#define PG8_MMA(ai, bj, At, Bt) do { __builtin_amdgcn_s_setprio(1); _Pragma("unroll") for (int m = 0; m < 4; ++m) _Pragma("unroll") for (int n = 0; n < 2; ++n) _Pragma("unroll") for (int k = 0; k < 2; ++k) \
        acc[ai][bj][m][n] = __builtin_amdgcn_mfma_f32_16x16x32_bf16(Bt[n][k], At[m][k], acc[ai][bj][m][n], 0, 0, 0); __builtin_amdgcn_s_setprio(0); } while (0)
#define PG8_WAIT_V(n) asm volatile("s_waitcnt vmcnt(" #n ")" ::: "memory")
#define PG8_WAIT_L(n) asm volatile("s_waitcnt lgkmcnt(" #n ")" ::: "memory")
#define PG8_BAR __builtin_amdgcn_s_barrier()
#define PG8_SCHED __builtin_amdgcn_sched_barrier(0)
#define PG8_GLOAD(uidx) do { _Pragma("unroll") for (int _i = 0; _i < 2; ++_i) { vA0[_i] = (unsigned)gtab[(uidx) * 256 + Rr[_i]] + (unsigned)Cc[_i] * 2u; vA1[_i] = (unsigned)gtab[(uidx) * 256 + 128 + Rr[_i]] + (unsigned)Cc[_i] * 2u; } } while (0)
    Unit cur, nxt; int ui = 0;
    if (!S.next(0, cur)) return;
    Acc acc;
#pragma unroll
    for (int a = 0; a < 2; ++a)
#pragma unroll
        for (int b = 0; b < 2; ++b)
#pragma unroll
            for (int m = 0; m < 4; ++m)
#pragma unroll
                for (int n = 0; n < 2; ++n) acc[a][b][m][n] = (f32x4){0.f, 0.f, 0.f, 0.f};
    bf16x8 At[4][2], B0[2][2], B1[2][2];
    if constexpr (GATHER) PG8_GLOAD(0);
    const char* cA = (const char*)g.A + (GATHER ? (size_t)0 : (size_t)cur.pm * tstep); const char* cB = (const char*)g.Bt + (size_t)S.b_tile(cur) * tstep;
    PG8_STAGE(PG8_SB(0, 0), cB, voffB); PG8_STAGE(PG8_SB(0, 1), cB + hstep, voffB); PG8_STAGE(PG8_SA(0, 0), cA, vA0); PG8_STAGE(PG8_SA(0, 1), cA + hstepA, vA1);
    if (wr == 1) PG8_BAR;
    PG8_WAIT_V(2); PG8_BAR;
    PG8_STAGE(PG8_SB(1, 0), cB + kstep, voffB); PG8_STAGE(PG8_SA(1, 0), cA + kstep, vA0); PG8_STAGE(PG8_SB(1, 1), cB + hstep + kstep, voffB);
    PG8_WAIT_V(6); PG8_BAR;
    for (;;) {
        const bool has_next = S.next(ui + 1, nxt);
        const char* nA = has_next ? (const char*)g.A + (GATHER ? (size_t)0 : (size_t)nxt.pm * tstep) : cA; const char* nB = has_next ? (const char*)g.Bt + (size_t)S.b_tile(nxt) * tstep : cB;
#pragma unroll 1
        for (int t = 0; t < nt; t += 2) {
            const bool last = (t == nt - 2);
            const char* a1 = cA + (size_t)(t + 1) * kstep;
            const char* a2 = last ? nA : cA + (size_t)(t + 2) * kstep; const char* b2 = last ? nB : cB + (size_t)(t + 2) * kstep;
            const char* a3 = a2 + kstep; const char* b3 = b2 + kstep;
            PG8_LDB(B0, 0, 0); PG8_LDB(B1, 0, 1); PG8_SCHED; PG8_LDA(At, 0, 0); PG8_STAGE(PG8_SA(1, 1), a1 + hstepA, vA1);
            PG8_WAIT_V(8); PG8_WAIT_L(0); PG8_BAR; PG8_MMA(0, 0, At, B0); PG8_MMA(0, 1, At, B1); PG8_BAR; PG8_SCHED;
            if constexpr (GATHER) { if (last && has_next) { PG8_GLOAD(ui + 1); } }
            PG8_LDA(At, 0, 1); PG8_STAGE(PG8_SB(0, 0), b2, voffB); PG8_STAGE(PG8_SB(0, 1), b2 + hstep, voffB); PG8_STAGE(PG8_SA(0, 0), a2, vA0);
            PG8_WAIT_V(8); PG8_WAIT_L(0); PG8_BAR; PG8_MMA(1, 0, At, B0); PG8_MMA(1, 1, At, B1); PG8_BAR; PG8_SCHED;
            PG8_LDB(B0, 1, 0); PG8_LDB(B1, 1, 1); PG8_SCHED; PG8_LDA(At, 1, 0); PG8_STAGE(PG8_SA(0, 1), a2 + hstepA, vA1);
            PG8_WAIT_V(8); PG8_WAIT_L(0); PG8_BAR; PG8_MMA(0, 0, At, B0); PG8_MMA(0, 1, At, B1); PG8_BAR; PG8_SCHED;
            PG8_LDA(At, 1, 1); PG8_STAGE(PG8_SB(1, 0), b3, voffB); PG8_STAGE(PG8_SB(1, 1), b3 + hstep, voffB); PG8_STAGE(PG8_SA(1, 0), a3, vA0);
            PG8_WAIT_V(8); PG8_WAIT_L(0); PG8_BAR; PG8_MMA(1, 0, At, B0); PG8_MMA(1, 1, At, B1); PG8_BAR; PG8_SCHED;
        }
        if (wr == 0) PG8_BAR;
        E(acc, cur, S, wr, wc, fr, fq);
        if (!has_next) break;
#pragma unroll
        for (int a = 0; a < 2; ++a)
#pragma unroll
            for (int b = 0; b < 2; ++b)
#pragma unroll
                for (int m = 0; m < 4; ++m)
#pragma unroll
                    for (int n = 0; n < 2; ++n) acc[a][b][m][n] = (f32x4){0.f, 0.f, 0.f, 0.f};
        cur = nxt; cA = nA; cB = nB; ++ui;
        if (wr == 1) PG8_BAR;
    }
    PG8_WAIT_V(0);
    PG8_BAR;
#undef PG8_SA
#undef PG8_SB
#undef PG8_STAGE
#undef PG8_LDA
#undef PG8_LDB
#undef PG8_MMA
#undef PG8_WAIT_V
#undef PG8_WAIT_L
#undef PG8_BAR
#undef PG8_SCHED
#undef PG8_GLOAD
}

struct EpiUQKV {
    static constexpr bool PERM = true;
    bf16_t* base; size_t stride;
    __device__ __forceinline__ void operator()(const Acc& acc, const Unit& u, const Order&, int wr, int wc, int fr, int fq) const {
        bf16_t* O = base + (size_t)(u.pn >> 1) * stride;
        const int row0 = u.pm * BM + wr * 64 + fr, col0 = (u.pn & 1) * 256 + wc * 32 + 8 * fq;
#pragma unroll
        for (int ai = 0; ai < 2; ++ai)
#pragma unroll
            for (int m = 0; m < 4; ++m) { bf16_t* rowp = O + (size_t)(row0 + ai * HALF + m * 16) * 512 + col0;
#pragma unroll
                for (int bj = 0; bj < 2; ++bj) { const f32x4 v0 = acc[ai][bj][m][0], v1 = acc[ai][bj][m][1];
                    u32x4 w; w.x = cvt_pk_bf16(v0[0], v0[1]); w.y = cvt_pk_bf16(v0[2], v0[3]); w.z = cvt_pk_bf16(v1[0], v1[1]); w.w = cvt_pk_bf16(v1[2], v1[3]);
                    *(u32x4*)(rowp + bj * HALF) = w; } }
    }
};
struct EpiBf16 {
    static constexpr bool PERM = true;
    bf16_t* O; int ldc;
    __device__ __forceinline__ void operator()(const Acc& acc, const Unit& u, const Order&, int wr, int wc, int fr, int fq) const {
        const int row0 = u.pm * BM + wr * 64 + fr, col0 = u.pn * BM + wc * 32 + 8 * fq;
#pragma unroll
        for (int ai = 0; ai < 2; ++ai)
#pragma unroll
            for (int m = 0; m < 4; ++m) { bf16_t* rowp = O + (size_t)(row0 + ai * HALF + m * 16) * ldc + col0;
#pragma unroll
                for (int bj = 0; bj < 2; ++bj) { const f32x4 v0 = acc[ai][bj][m][0], v1 = acc[ai][bj][m][1];
                    u32x4 w; w.x = cvt_pk_bf16(v0[0], v0[1]); w.y = cvt_pk_bf16(v0[2], v0[3]); w.z = cvt_pk_bf16(v1[0], v1[1]); w.w = cvt_pk_bf16(v1[2], v1[3]);
                    *(u32x4*)(rowp + bj * HALF) = w; } }
    }
};
struct EpiResF32 {
    static constexpr bool PERM = false;
    const float* base; float* out;
    __device__ __forceinline__ void operator()(const Acc& acc, const Unit& u, const Order&, int wr, int wc, int fr, int fq) const {
        const int row0 = u.pm * BM + wr * 64 + fr, col0 = u.pn * BM + wc * 32 + 4 * fq;
#pragma unroll
        for (int ai = 0; ai < 2; ++ai)
#pragma unroll
            for (int m = 0; m < 4; ++m) { const size_t off = (size_t)(row0 + ai * HALF + m * 16) * D + col0;
#pragma unroll
                for (int bj = 0; bj < 2; ++bj)
#pragma unroll
                    for (int n = 0; n < 2; ++n) { const f32x4 b = *(const f32x4*)(base + off + bj * HALF + n * 16); *(f32x4*)(out + off + bj * HALF + n * 16) = b + acc[ai][bj][m][n]; } }
    }
};
struct EpiSwiGLU {
    static constexpr bool PERM = true;
    bf16_t* H; const float* bgu;
    __device__ __forceinline__ void operator()(const Acc& acc, const Unit& u, const Order& S, int wr, int wc, int fr, int fq) const {
        const int e = S.expert(u);
        const int row0 = u.pm * BM + wr * 64 + fr, j0 = u.pn * 128 + wc * 32 + 8 * fq;
        const float* bg = bgu + (size_t)e * 2048 + j0; const float* bu = bg + 1024;
        const f32x4 bg0 = *(const f32x4*)bg, bg1 = *(const f32x4*)(bg + 4), bu0 = *(const f32x4*)bu, bu1 = *(const f32x4*)(bu + 4);
#pragma unroll
        for (int ai = 0; ai < 2; ++ai)
#pragma unroll
            for (int m = 0; m < 4; ++m) {
                float hv[8];
#pragma unroll
                for (int n = 0; n < 2; ++n) { const f32x4 gq = acc[ai][0][m][n] + (n ? bg1 : bg0), uq = acc[ai][1][m][n] + (n ? bu1 : bu0);
#pragma unroll
                    for (int x = 0; x < 4; ++x) { const float gg = fminf(gq[x], 7.0f), uu = fminf(fmaxf(uq[x], -7.0f), 7.0f);
                        hv[n * 4 + x] = (uu + 1.0f) * gg * __builtin_amdgcn_rcpf(1.0f + __builtin_amdgcn_exp2f(-1.702f * LOG2E * gg)); } }
                u32x4 w; w.x = cvt_pk_bf16(hv[0], hv[1]); w.y = cvt_pk_bf16(hv[2], hv[3]); w.z = cvt_pk_bf16(hv[4], hv[5]); w.w = cvt_pk_bf16(hv[6], hv[7]);
                *(u32x4*)(H + (size_t)(row0 + ai * HALF + m * 16) * 1024 + j0) = w; }
    }
};
struct EpiDown {
    static constexpr bool PERM = true;
    bf16_t* Y; const float* bdn;
    __device__ __forceinline__ void operator()(const Acc& acc, const Unit& u, const Order& S, int wr, int wc, int fr, int fq) const {
        const int e = S.expert(u);
        const int row0 = u.pm * BM + wr * 64 + fr, col0 = u.pn * BM + wc * 32 + 8 * fq;
        const float* bp = bdn + (size_t)e * 1024 + col0;
#pragma unroll
        for (int bj = 0; bj < 2; ++bj) { const f32x4 b0 = *(const f32x4*)(bp + bj * HALF), b1 = *(const f32x4*)(bp + bj * HALF + 4);
#pragma unroll
            for (int ai = 0; ai < 2; ++ai)
#pragma unroll
                for (int m = 0; m < 4; ++m) { const f32x4 v0 = acc[ai][bj][m][0] + b0, v1 = acc[ai][bj][m][1] + b1;
                    u32x4 w; w.x = cvt_pk_bf16(v0[0], v0[1]); w.y = cvt_pk_bf16(v0[2], v0[3]); w.z = cvt_pk_bf16(v1[0], v1[1]); w.w = cvt_pk_bf16(v1[2], v1[3]);
                    *(u32x4*)(Y + (size_t)(row0 + ai * HALF + m * 16) * 1024 + col0 + bj * HALF) = w; } }
    }
};
struct EpiPle {
    static constexpr bool PERM = false;
    const float* x2; const bf16_t* pp; float* out; float* rowss;
    __device__ __forceinline__ void operator()(const Acc& acc, const Unit& u, const Order&, int wr, int wc, int fr, int fq) const {
        const int row0 = u.pm * BM + wr * 64 + fr, col0 = u.pn * BM + wc * 32 + 4 * fq;
#pragma unroll
        for (int ai = 0; ai < 2; ++ai)
#pragma unroll
            for (int m = 0; m < 4; ++m) { const int row = row0 + ai * HALF + m * 16; const size_t off = (size_t)row * D + col0; float ss = 0.f;
#pragma unroll
                for (int bj = 0; bj < 2; ++bj)
#pragma unroll
                    for (int n = 0; n < 2; ++n) { const size_t o2 = off + bj * HALF + n * 16; const f32x4 xb = *(const f32x4*)(x2 + o2); const u32x2 pw = *(const u32x2*)(pp + o2);
                        const f32x4 a = acc[ai][bj][m][n]; f32x4 r;
                        r[0] = xb[0] + bflo(pw.x) * sigmoidf_fast(a[0]); r[1] = xb[1] + bfhi(pw.x) * sigmoidf_fast(a[1]);
                        r[2] = xb[2] + bflo(pw.y) * sigmoidf_fast(a[2]); r[3] = xb[3] + bfhi(pw.y) * sigmoidf_fast(a[3]);
                        ss += (r[0] * r[0] + r[1] * r[1]) + (r[2] * r[2] + r[3] * r[3]);
                        *(f32x4*)(out + o2) = r; }
                ss += __shfl_xor(ss, 16); ss += __shfl_xor(ss, 32);
                if (fq == 0) atomicAdd(rowss + row, ss); }
    }
};
}
namespace mk {
constexpr size_t MiB = 1u << 20;
constexpr size_t WS_CTL = 0, CTL_ZERO_BYTES = 1 * MiB;
constexpr int CW_TMO = 0, CW_CNT = 64, CW_BAR = 4096;
constexpr size_t WS_ROWSS = 512 * 1024;
constexpr size_t WS_BIAS = 1 * MiB;
constexpr size_t WS_WPT = 1 * MiB + 64 * 1024;
constexpr size_t WS_WT_PP = 2 * MiB;
constexpr size_t WS_WT_IN = 4 * MiB;
constexpr size_t WS_WT_OUT = 8 * MiB;
constexpr size_t WS_WT_PG = 10 * MiB;
constexpr size_t WS_LIST = 12 * MiB;
constexpr size_t WS_TOKINFO = 14 * MiB;
constexpr size_t WS_LSE = 15 * MiB;
constexpr size_t WS_PB = 17 * MiB;
constexpr size_t WS_WT_GU = 32 * MiB;
constexpr size_t WS_WT_DN = 160 * MiB;
constexpr size_t WS_XN = 224 * MiB;
constexpr size_t WS_UQKV = 256 * MiB;
constexpr size_t WS_OB = 320 * MiB;
constexpr size_t WS_MIX = 368 * MiB;
constexpr size_t WS_PPB = 400 * MiB;
constexpr size_t WS_X1 = 432 * MiB;
constexpr size_t WS_X2 = 496 * MiB;
constexpr size_t WS_H = 560 * MiB;
constexpr size_t WS_Y = 704 * MiB;
constexpr size_t WS_END = 848 * MiB;

constexpr int RING_BYTES = 131072;
constexpr int L_MISC = RING_BYTES;
constexpr int L_CNT = L_MISC + 256;
constexpr int L_BASE = L_CNT + 128;
constexpr int L_TILE_E = L_BASE + 256;
constexpr int L_GTAB = L_TILE_E + 1280;
constexpr int MAXU = 12;
constexpr int LDS_BYTES = 163840;
static_assert(L_GTAB + MAXU * 1024 <= LDS_BYTES, "LDS map");

typedef GAS unsigned gu32;
#define RLX_AGENT __ATOMIC_RELAXED, __HIP_MEMORY_SCOPE_AGENT
#define LDS_WAIT() asm volatile("s_waitcnt lgkmcnt(0)" ::: "memory")
#define VM_WAIT() asm volatile("s_waitcnt vmcnt(0)" ::: "memory")

#define XB_TMO      128
#define XB_XCNT(j)  (256  + 64 * (j))
#define XB_XSUB(j)  (1280 + 64 * (j))
#define XB_XGEN(j)  (2304 + 64 * (j))
#define XB_TOP      3328
#define XB_TOPGEN   3392
#define XCD_BAR_WORDS 3456
#define XB_SPIN_CAP (1u << 18)
__device__ __forceinline__ unsigned xb_ld(unsigned* p)              { return __hip_atomic_load(p, __ATOMIC_RELAXED, __HIP_MEMORY_SCOPE_AGENT); }
__device__ __forceinline__ unsigned xb_add(unsigned* p, unsigned v) { return __hip_atomic_fetch_add(p, v, __ATOMIC_RELAXED, __HIP_MEMORY_SCOPE_AGENT); }
__device__ __forceinline__ unsigned xb_xcc_id() { return (unsigned)__builtin_amdgcn_s_getreg((3 << 11) | 20) & 0xFu; }
#define XB_SPIN(cond, bar) do { unsigned _sp = 0; while (cond) { __builtin_amdgcn_s_sleep(1); \
    if ((++_sp & 255u) == 0u) { if (xb_ld(&(bar)[XB_TMO])) break; if (_sp > XB_SPIN_CAP) { atomicAdd(&(bar)[XB_TMO], 1u); break; } } } } while (0)
struct XcdBarrier { unsigned* bar; unsigned x; volatile LAS unsigned* st; };
__device__ __forceinline__ XcdBarrier xcd_barrier_post(unsigned* bar, volatile LAS unsigned* st) {
    XcdBarrier b; b.bar = bar; b.x = xb_xcc_id(); b.st = st;
    if (threadIdx.x == 0) (void)xb_add(&bar[XB_XCNT(b.x)], 1u);
    return b;
}
__device__ __forceinline__ void xcd_barrier_complete(unsigned* bar, unsigned x, unsigned& nloc, unsigned& nx) {
    const unsigned G = gridDim.x * gridDim.y * gridDim.z;
    unsigned sum, cnt, mine, sp = 0u;
    for (;;) {
        sum = 0u; cnt = 0u; mine = 0u;
#pragma unroll
        for (unsigned j = 0; j < 16; ++j) { const unsigned c = xb_ld(&bar[XB_XCNT(j)]); sum += c; cnt += (c > 0u) ? 1u : 0u; mine = (j == x) ? c : mine; }
        if (sum == G) break;
        __builtin_amdgcn_s_sleep(1);
        if ((++sp & 255u) == 0u) { if (xb_ld(&bar[XB_TMO])) break; if (sp > XB_SPIN_CAP) { atomicAdd(&bar[XB_TMO], 1u); break; } }
    }
    nloc = mine > 0u ? mine : 1u; nx = cnt > 0u ? cnt : 1u;
}
__device__ __forceinline__ void xcd_barrier(const XcdBarrier& b) {
    asm volatile("s_waitcnt vmcnt(0)" ::: "memory");
    __syncthreads();
    if (threadIdx.x == 0) {
        unsigned* bar = b.bar;
        __builtin_amdgcn_s_waitcnt(0);
        unsigned nloc = b.st[0], nx = b.st[1];
        if (nloc == 0u) { xcd_barrier_complete(bar, b.x, nloc, nx); b.st[0] = nloc; b.st[1] = nx; }
        const unsigned old = xb_add(&bar[XB_XSUB(b.x)], 1u);
        const unsigned gen = old / nloc;
        if (old + 1u == (gen + 1u) * nloc) {
            __builtin_amdgcn_fence(__ATOMIC_RELEASE, "agent");
            asm volatile("s_waitcnt vmcnt(0)" ::: "memory");
            const unsigned og = xb_add(&bar[XB_TOP], 1u);
            const unsigned tg = og / nx;
            if (og + 1u == (tg + 1u) * nx) xb_add(&bar[XB_TOPGEN], 1u);
            else XB_SPIN(xb_ld(&bar[XB_TOPGEN]) == tg, bar);
            __builtin_amdgcn_fence(__ATOMIC_ACQUIRE, "agent");
            xb_add(&bar[XB_XGEN(b.x)], 1u);
            asm volatile("s_waitcnt vmcnt(0)" ::: "memory");
        } else {
            XB_SPIN(xb_ld(&bar[XB_XGEN(b.x)]) == gen, bar);
            __builtin_amdgcn_fence(__ATOMIC_ACQUIRE, "agent");
            asm volatile("s_waitcnt vmcnt(0)" ::: "memory");
        }
    }
    __syncthreads();
}

struct Frame {
    LAS unsigned char* lds;
    int tid, lane, wave, vcu, G;
    unsigned char* ws;
    const float* in[19];
    float* out;
};
__device__ __forceinline__ unsigned f2bf(float f) { unsigned u = __builtin_bit_cast(unsigned, f); return (u + 0x7fffu + ((u >> 16) & 1u)) >> 16; }
__device__ __forceinline__ unsigned pk2(float lo, float hi) { return f2bf(lo) | (f2bf(hi) << 16); }

__device__ __forceinline__ void p0_transpose_item(const float* W, int K, int N, bf16_t* WT, int k0, int n0, int drow0, LAS float* scr, int lane, float scale = 1.0f) {
#pragma unroll 8
    for (int i = 0; i < 32; ++i) { const int kk = 2 * i + (lane >> 5); scr[kk * 33 + (lane & 31)] = W[(size_t)(k0 + kk) * N + n0 + (lane & 31)] * scale; }
    LDS_WAIT(); asm volatile("" ::: "memory");
    const int c = lane & 7;
#pragma unroll
    for (int j = 0; j < 4; ++j) { const int n = (lane >> 3) + 8 * j; const LAS float* s = scr + (8 * c) * 33 + n;
        u32x4 o; o.x = pk2(s[0 * 33], s[1 * 33]); o.y = pk2(s[2 * 33], s[3 * 33]); o.z = pk2(s[4 * 33], s[5 * 33]); o.w = pk2(s[6 * 33], s[7 * 33]);
        *(GAS u32x4*)(WT + (size_t)(drow0 + n) * K + k0 + 8 * c) = o; }
    LDS_WAIT(); asm volatile("" ::: "memory");
}
__device__ __forceinline__ int t5_bucket(int dist) {
    if (dist < 16) return dist;
    const float n = (float)dist;
    int large = 16 + (int)(logf(n / 16.0f) / logf(128.0f) * 16.0f);
    return large < 31 ? large : 31;
}
__device__ __forceinline__ void rms_row_to_bf16(const float* xrow, const float* g, bf16_t* orow, int lane) {
    const f32x4* xr = (const f32x4*)xrow + lane; const f32x4* gr = (const f32x4*)g + lane;
    f32x4 v[4]; float s = 0.f;
#pragma unroll
    for (int j = 0; j < 4; ++j) { v[j] = xr[64 * j]; s += (v[j].x * v[j].x + v[j].y * v[j].y) + (v[j].z * v[j].z + v[j].w * v[j].w); }
    const float rstd = 1.f / sqrtf(wave_sum(s) * (1.f / D) + EPS);
    unsigned long long* o8 = (unsigned long long*)orow + lane;
#pragma unroll
    for (int j = 0; j < 4; ++j) { const f32x4 gg = gr[64 * j];
        o8[64 * j] = (unsigned long long)pk2(v[j].x * rstd * gg.x, v[j].y * rstd * gg.y) | ((unsigned long long)pk2(v[j].z * rstd * gg.z, v[j].w * rstd * gg.w) << 32); }
}
__device__ __forceinline__ void p0_prologue(Frame& F) {
    LAS float* scr = (LAS float*)(F.lds + F.wave * 16384);
    const int gw = F.vcu * 8 + F.wave, NGW = F.G * 8, lane = F.lane;
    const float* w_in = F.in[3]; const float* w_pool = F.in[4]; const float* w_out = F.in[7]; const float* w_gu = F.in[11]; const float* w_dn = F.in[13];
    const float* w_pg = F.in[16]; const float* w_pp = F.in[17];
    bf16_t* WT_IN = (bf16_t*)(F.ws + WS_WT_IN); bf16_t* WT_OUT = (bf16_t*)(F.ws + WS_WT_OUT); bf16_t* WT_PG = (bf16_t*)(F.ws + WS_WT_PG); bf16_t* WT_PP = (bf16_t*)(F.ws + WS_WT_PP);
    bf16_t* WPT = (bf16_t*)(F.ws + WS_WPT); bf16_t* WT_GU = (bf16_t*)(F.ws + WS_WT_GU); bf16_t* WT_DN = (bf16_t*)(F.ws + WS_WT_DN);
    constexpr int I_IN = 16 * 64, I_OUT = 16 * 32, I_PG = 16 * 32, I_PP = 4 * 32, I_POOL = 4 * 2 * 4, I_GU = 32 * 16 * 64, I_DN = 32 * 16 * 32;
    constexpr int NITEMS = I_IN + I_OUT + I_PG + I_PP + I_POOL + I_GU + I_DN;
    for (int it = gw; it < NITEMS; it += NGW) {
        int r = it;
        if (r < I_GU) { const int e = r / 1024, q = r % 1024, kb = q / 64, nb = q % 64, n0 = nb * 32;
            const int half = n0 >> 10, j = n0 & 1023, pn = j >> 7, jj = j & 127;
            p0_transpose_item(w_gu + (size_t)e * 1024 * 2048, 1024, 2048, WT_GU + (size_t)e * 2048 * 1024, kb * 64, n0, pn * 256 + half * 128 + jj, scr, lane); continue; } r -= I_GU;
        if (r < I_DN) { const int e = r / 512, q = r % 512, kb = q / 32, nb = q % 32;
            p0_transpose_item(w_dn + (size_t)e * 1024 * 1024, 1024, 1024, WT_DN + (size_t)e * 1024 * 1024, kb * 64, nb * 32, nb * 32, scr, lane); continue; } r -= I_DN;
        if (r < I_IN) { const int kb = r / 64, nb = r % 64; p0_transpose_item(w_in, 1024, 2048, WT_IN, kb * 64, nb * 32, nb * 32, scr, lane, (nb >= 16 && nb < 32) ? QSCALE : 1.0f); continue; } r -= I_IN;
        if (r < I_OUT) { const int kb = r / 32, nb = r % 32; p0_transpose_item(w_out, 1024, 1024, WT_OUT, kb * 64, nb * 32, nb * 32, scr, lane); continue; } r -= I_OUT;
        if (r < I_PG) { const int kb = r / 32, nb = r % 32; p0_transpose_item(w_pg, 1024, 1024, WT_PG, kb * 64, nb * 32, nb * 32, scr, lane); continue; } r -= I_PG;
        if (r < I_PP) { const int kb = r / 32, nb = r % 32; p0_transpose_item(w_pp, 256, 1024, WT_PP, kb * 64, nb * 32, nb * 32, scr, lane); continue; } r -= I_PP;
        { const int g = r / 8, q = r % 8, kb = q / 4, nb = q % 4; p0_transpose_item(w_pool + (size_t)g * 128 * 128, 128, 128, WPT + (size_t)g * 128 * 128, kb * 64, nb * 32, nb * 32, scr, lane); }
    }
    bf16_t* XN = (bf16_t*)(F.ws + WS_XN);
    for (int m = gw; m < T; m += NGW) rms_row_to_bf16(F.in[0] + (size_t)m * D, F.in[2], XN + (size_t)m * D, lane);
    bf16_t* PB = (bf16_t*)(F.ws + WS_PB);
    for (int m = gw; m < T; m += NGW) { const f32x4 v = ((const f32x4*)(F.in[1] + (size_t)m * PLE))[lane];
        ((unsigned long long*)(PB + (size_t)m * PLE))[lane] = (unsigned long long)pk2(v.x, v.y) | ((unsigned long long)pk2(v.z, v.w) << 32); }
    if (blockIdx.x == 0) { float* BT = (float*)(F.ws + WS_BIAS);
        for (int i = F.tid; i < 3 * 8 * 132; i += 512) { const int br = i / (8 * 132), h = (i / 132) % 8, rel = i % 132; const int dil = br == 0 ? 1 : (br == 1 ? 4 : 16);
            BT[i] = rel <= 128 ? F.in[6][t5_bucket(rel * dil) * 8 + h] * LOG2E : 0.f; } }
}

__device__ __forceinline__ int fK(int row) { return (row >> 1) & 7; }
__device__ __forceinline__ int fV(int row) { return ((row >> 1) & 1) << 2; }
__device__ __forceinline__ int crow(int r, int hi) { return (r & 3) + 8 * (r >> 2) + 4 * hi; }
__device__ __forceinline__ s16x4 tr_read(LAS const unsigned char* p) { typedef short v4i16_t __attribute__((ext_vector_type(4)));
    return __builtin_bit_cast(s16x4, __builtin_amdgcn_ds_read_tr16_b64_v4i16((LAS v4i16_t*)p)); }
__device__ __forceinline__ void attn_phase(Frame& F) {
    const int lane = F.lane, w = F.wave, r32 = lane & 31, hi = lane >> 5;
    const bf16_t* QB = (const bf16_t*)(F.ws + WS_UQKV) + (size_t)1 * T * 512; const bf16_t* KB = QB + (size_t)T * 512; const bf16_t* VB = KB + (size_t)T * 512;
    bf16_t* OB = (bf16_t*)(F.ws + WS_OB); float* LSE = (float*)(F.ws + WS_LSE); const float* BT = (const float*)(F.ws + WS_BIAS);
    LAS unsigned char* Kl = F.lds; LAS unsigned char* Vl = F.lds + 49152;
    constexpr int NITEM = 4 * 8 * 3 * 16;
    const int ipc = (NITEM + F.G - 1) / F.G;
    for (int it = F.vcu * ipc; it < NITEM && it < (F.vcu + 1) * ipc; ++it) {
        const int bh = it / 48, sub = it % 48, br = sub / 16, q16 = sub % 16;
        const int b = bh >> 3, h = bh & 7;
        const int dsh = br * 2, d = 1 << dsh;
        const int nblk = 16 >> dsh;
        const int r = q16 / nblk, m = q16 % nblk;
        const int lbase = 256 * m - 128;
        const size_t rowb = (size_t)b * S;
#pragma unroll
        for (int pi = 0; pi < 6; ++pi) { const int piece = w + 8 * pi, row = piece * 8 + (lane >> 3), cp = lane & 7;
            int lp = lbase + row; lp = lp < 0 ? 0 : lp;
            const size_t tok = rowb + (size_t)lp * d + r;
            const bf16_t* ks = KB + tok * 512 + h * 64 + ((cp ^ fK(row)) << 3);
            const bf16_t* vs = VB + tok * 512 + h * 64 + ((cp ^ fV(row)) << 3);
            __builtin_amdgcn_global_load_lds((const unsigned*)ks, (LAS unsigned*)(Kl + piece * 1024), 16, 0, 0);
            __builtin_amdgcn_global_load_lds((const unsigned*)vs, (LAS unsigned*)(Vl + piece * 1024), 16, 0, 0); }
        const int lq = 256 * m + 32 * w + r32;
        const size_t qtok = rowb + (size_t)lq * d + r;
        bf16x8 qf[4];
#pragma unroll
        for (int d0 = 0; d0 < 4; ++d0) qf[d0] = *(const bf16x8*)(QB + qtok * 512 + h * 64 + d0 * 16 + hi * 8);
        LAS float* btl = (LAS float*)(F.lds + 98304);
        if (F.tid < 132) btl[F.tid] = BT[(br * 8 + h) * 132 + F.tid];
        VM_WAIT(); LDS_WAIT(); __syncthreads();
        f32x16 p[5];
        int r32v = r32, hiv = hi; asm volatile("" : "+v"(r32v), "+v"(hiv));
        float mx = -3.0e38f;
#pragma unroll
        for (int jt = 0; jt < 5; ++jt) {
            const int krow = 32 * w + 32 * jt + r32;
            f32x16 acc = {};
#pragma unroll
            for (int d0 = 0; d0 < 4; ++d0) { const bf16x8 kf = *(const LAS bf16x8*)(Kl + krow * 128 + (((2 * d0 + hi) ^ fK(krow)) << 4));
                acc = __builtin_amdgcn_mfma_f32_32x32x16_bf16(kf, qf[d0], acc, 0, 0, 0); }
#pragma unroll
            for (int rr = 0; rr < 16; ++rr) { const int kk = crow(rr, hiv); const int rel = 128 + r32v - 32 * jt - kk; const int lp = lbase + 32 * w + 32 * jt + kk;
                const bool ok = (rel >= 0) && (rel <= 128) && (lp >= 0);
                const float sv = ok ? acc[rr] + btl[ok ? rel : 0] : -3.0e38f;
                acc[rr] = sv; mx = fmaxf(mx, sv); }
            p[jt] = acc;
            __builtin_amdgcn_sched_barrier(0);
        }
        { const float o = __shfl_xor(mx, 32); mx = fmaxf(mx, o); }
        float ls = 0.f;
#pragma unroll
        for (int jt = 0; jt < 5; ++jt)
#pragma unroll
            for (int rr = 0; rr < 16; ++rr) { const float e = __builtin_amdgcn_exp2f(p[jt][rr] - mx); p[jt][rr] = e; ls += e; }
        ls += __shfl_xor(ls, 32);
        __builtin_amdgcn_sched_barrier(0);
        f32x16 o[2]; o[0] = (f32x16){}; o[1] = (f32x16){};
#pragma unroll
        for (int jt = 0; jt < 5; ++jt)
#pragma unroll
            for (int s = 0; s < 2; ++s) {
                u32x4 pw; pw.x = cvt_pk_bf16(p[jt][8 * s + 0], p[jt][8 * s + 1]); pw.y = cvt_pk_bf16(p[jt][8 * s + 2], p[jt][8 * s + 3]);
                pw.z = cvt_pk_bf16(p[jt][8 * s + 4], p[jt][8 * s + 5]); pw.w = cvt_pk_bf16(p[jt][8 * s + 6], p[jt][8 * s + 7]);
                const bf16x8 pf = __builtin_bit_cast(bf16x8, pw);
                const int g = lane >> 4, qq = (lane & 15) >> 2, pp = lane & 3;
                const int key0 = 32 * w + 32 * jt + 16 * s + 4 * (g >> 1);
#pragma unroll
                for (int d0 = 0; d0 < 2; ++d0) {
                    const int dcol = 32 * d0 + 16 * (g & 1) + 4 * pp;
                    const int ra = key0 + qq, rb = key0 + 8 + qq;
                    const s16x4 lo = tr_read(Vl + ra * 128 + (((dcol >> 3) ^ fV(ra)) << 4) + (dcol & 7) * 2);
                    const s16x4 hh = tr_read(Vl + rb * 128 + (((dcol >> 3) ^ fV(rb)) << 4) + (dcol & 7) * 2);
                    const bf16x8 vf = (bf16x8){lo[0], lo[1], lo[2], lo[3], hh[0], hh[1], hh[2], hh[3]};
                    o[d0] = __builtin_amdgcn_mfma_f32_32x32x16_bf16(vf, pf, o[d0], 0, 0, 0);
                }
                __builtin_amdgcn_sched_barrier(0);
            }
        const float inv = 1.0f / ls;
        bf16_t* op = OB + ((size_t)br * T + qtok) * 512 + h * 64;
#pragma unroll
        for (int d0 = 0; d0 < 2; ++d0)
#pragma unroll
            for (int g4 = 0; g4 < 4; ++g4) { u32x2 wv; wv.x = cvt_pk_bf16(o[d0][4 * g4 + 0] * inv, o[d0][4 * g4 + 1] * inv); wv.y = cvt_pk_bf16(o[d0][4 * g4 + 2] * inv, o[d0][4 * g4 + 3] * inv);
                *(u32x2*)(op + 32 * d0 + 8 * g4 + 4 * hi) = wv; }
        if (hi == 0) LSE[((size_t)br * T + qtok) * 8 + h] = mx + __builtin_amdgcn_logf(ls);
        LDS_WAIT(); __syncthreads();
    }
}

__device__ __forceinline__ void merge_pool_phase(Frame& F) {
    const int gw = F.vcu * 8 + F.wave, NGW = F.G * 8, lane = F.lane;
    const bf16_t* OB = (const bf16_t*)(F.ws + WS_OB); const float* LSE = (const float*)(F.ws + WS_LSE); bf16_t* MIX = (bf16_t*)(F.ws + WS_MIX);
    for (int t = gw; t < T; t += NGW) {
        const int h = lane >> 3;
        const float l0 = LSE[((size_t)0 * T + t) * 8 + h], l1 = LSE[((size_t)1 * T + t) * 8 + h], l2 = LSE[((size_t)2 * T + t) * 8 + h];
        const float mm = fmaxf(l0, fmaxf(l1, l2));
        float w0 = __builtin_amdgcn_exp2f(l0 - mm), w1 = __builtin_amdgcn_exp2f(l1 - mm), w2 = __builtin_amdgcn_exp2f(l2 - mm);
        const float inv = 1.0f / (w0 + w1 + w2); w0 *= inv; w1 *= inv; w2 *= inv;
        const u32x4 a = *(const u32x4*)(OB + ((size_t)0 * T + t) * 512 + lane * 8), bq = *(const u32x4*)(OB + ((size_t)1 * T + t) * 512 + lane * 8), c = *(const u32x4*)(OB + ((size_t)2 * T + t) * 512 + lane * 8);
        u32x4 o;
#pragma unroll
        for (int i = 0; i < 4; ++i) { const float lo = w0 * bflo(a[i]) + w1 * bflo(bq[i]) + w2 * bflo(c[i]), hi = w0 * bfhi(a[i]) + w1 * bfhi(bq[i]) + w2 * bfhi(c[i]); o[i] = cvt_pk_bf16(lo, hi); }
        *(u32x4*)(MIX + (size_t)t * 1024 + 512 + lane * 8) = o;
    }
    const bf16_t* UB = (const bf16_t*)(F.ws + WS_UQKV); const bf16_t* WPT = (const bf16_t*)(F.ws + WS_WPT); const float* pscale = F.in[5];
    const int r32 = lane & 31, hi = lane >> 5;
    for (int it = gw; it < (T / 32) * 4; it += NGW) {
        const int g = it & 3, t0 = (it >> 2) * 32, tok = t0 + r32, tin = tok & (S - 1), wdw = 2 << g;
        const int cnt = (tin + 1 < wdw) ? tin + 1 : wdw; const float rc = 1.0f / (float)cnt;
        bf16x8 bfrag[8];
#pragma unroll
        for (int s = 0; s < 8; ++s) {
            const bf16_t* up = UB + (size_t)tok * 512 + g * 128 + 16 * s + 8 * hi;
            float sum[8]; const u32x4 cur = *(const u32x4*)up;
#pragma unroll
            for (int i = 0; i < 4; ++i) { sum[2 * i] = bflo(cur[i]); sum[2 * i + 1] = bfhi(cur[i]); }
            for (int j = 1; j < cnt; ++j) { const u32x4 v = *(const u32x4*)(up - (size_t)j * 512);
#pragma unroll
                for (int i = 0; i < 4; ++i) { sum[2 * i] += bflo(v[i]); sum[2 * i + 1] += bfhi(v[i]); } }
            u32x4 pw;
#pragma unroll
            for (int i = 0; i < 4; ++i) pw[i] = cvt_pk_bf16(sum[2 * i] * rc - bflo(cur[i]), sum[2 * i + 1] * rc - bfhi(cur[i]));
            bfrag[s] = __builtin_bit_cast(bf16x8, pw);
        }
#pragma unroll
        for (int db = 0; db < 4; ++db) {
            f32x16 acc = {};
#pragma unroll
            for (int s = 0; s < 8; ++s) { const bf16x8 af = *(const bf16x8*)(WPT + ((size_t)g * 128 + 32 * db + r32) * 128 + 16 * s + 8 * hi);
                acc = __builtin_amdgcn_mfma_f32_32x32x16_bf16(af, bfrag[s], acc, 0, 0, 0); }
#pragma unroll
            for (int g4 = 0; g4 < 4; ++g4) { const int dd = g * 128 + 32 * db + 8 * g4 + 4 * hi; const f32x4 sc = *(const f32x4*)(pscale + dd);
                u32x2 wv; wv.x = cvt_pk_bf16(acc[4 * g4 + 0] * sc[0], acc[4 * g4 + 1] * sc[1]); wv.y = cvt_pk_bf16(acc[4 * g4 + 2] * sc[2], acc[4 * g4 + 3] * sc[3]);
                *(u32x2*)(MIX + (size_t)tok * 1024 + dd) = wv; }
        }
    }
}
}
namespace mk {
__device__ __forceinline__ void router_phase(Frame& F) {
    const int lane = F.lane, gw = F.vcu * 8 + F.wave, NGW = F.G * 8;
    const float* X1 = (const float*)(F.ws + WS_X1); const float* g_ffn = F.in[8]; const float* w_r = F.in[9]; const float* b_r = F.in[10];
    bf16_t* XN = (bf16_t*)(F.ws + WS_XN); int* LIST = (int*)(F.ws + WS_LIST); u32x2* TOKINFO = (u32x2*)(F.ws + WS_TOKINFO);
    unsigned* cntg = (unsigned*)(F.ws + WS_CTL) + CW_CNT;
    LAS f32x4* wl = (LAS f32x4*)F.lds;
    for (int i = F.tid; i < 1024 * 8; i += 512) { const int k = i >> 3, c = i & 7; f32x4 v = *(const f32x4*)(w_r + (size_t)k * 32 + c * 4); v = v * g_ffn[k]; wl[k * 8 + (c ^ ((k >> 1) & 7))] = v; }
    LDS_WAIT(); __syncthreads();
    const float bias_e = b_r[(lane >> 1) & 31];
    for (int t0 = gw * 2; t0 < T; t0 += NGW * 2) {
        float xa[16], xb[16]; float sa = 0.f, sb = 0.f;
#pragma unroll
        for (int i = 0; i < 16; ++i) { xa[i] = X1[(size_t)t0 * D + lane + 64 * i]; xb[i] = X1[(size_t)(t0 + 1) * D + lane + 64 * i]; sa += xa[i] * xa[i]; sb += xb[i] * xb[i]; }
        const float ra = 1.f / sqrtf(wave_sum(sa) * (1.f / D) + EPS), rb = 1.f / sqrtf(wave_sum(sb) * (1.f / D) + EPS);
        float aa[32], ab[32];
#pragma unroll
        for (int e = 0; e < 32; ++e) { aa[e] = 0.f; ab[e] = 0.f; }
#pragma unroll
        for (int i = 0; i < 16; ++i) { const int k = lane + 64 * i; const float va = xa[i], vb = xb[i];
#pragma unroll
            for (int c = 0; c < 8; ++c) { const f32x4 wv = wl[k * 8 + (c ^ ((k >> 1) & 7))];
#pragma unroll
                for (int x = 0; x < 4; ++x) { aa[4 * c + x] = fmaf(va, wv[x], aa[4 * c + x]); ab[4 * c + x] = fmaf(vb, wv[x], ab[4 * c + x]); } }
            asm volatile("" ::: "memory"); }
#pragma unroll
        for (int i = 0; i < 16; ++i) { const int k = lane + 64 * i; const float gk = g_ffn[k];
            XN[(size_t)t0 * D + k] = (bf16_t)f2bf(xa[i] * ra * gk); XN[(size_t)(t0 + 1) * D + k] = (bf16_t)f2bf(xb[i] * rb * gk); }
#define RSTEP(N, MASK) \
        _Pragma("unroll") for (int i = 0; i < N; ++i) { const bool up = (lane & MASK) != 0; \
            { const float keep = up ? aa[i + N] : aa[i], send = up ? aa[i] : aa[i + N]; aa[i] = keep + __shfl_xor(send, MASK); } \
            { const float keep = up ? ab[i + N] : ab[i], send = up ? ab[i] : ab[i + N]; ab[i] = keep + __shfl_xor(send, MASK); } }
        RSTEP(16, 32) RSTEP(8, 16) RSTEP(4, 8) RSTEP(2, 4) RSTEP(1, 2)
#undef RSTEP
        float la = aa[0] + __shfl_xor(aa[0], 1), lb = ab[0] + __shfl_xor(ab[0], 1);
        la = la * ra + bias_e; lb = lb * rb + bias_e;
        const int my_e = (lane >> 1) & 31;
#pragma unroll
        for (int row = 0; row < 2; ++row) {
            float v = row ? lb : la; const int t = t0 + row;
            float tv[4]; int ti[4];
#pragma unroll
            for (int k = 0; k < 4; ++k) {
                float bv = v; int bi = my_e;
#pragma unroll
                for (int o = 2; o < 64; o <<= 1) { const float ov = __shfl_xor(bv, o); const int oi = __shfl_xor(bi, o); if (ov > bv || (ov == bv && oi < bi)) { bv = ov; bi = oi; } }
                tv[k] = bv; ti[k] = bi; if (my_e == bi) v = -INFINITY;
            }
            const float e1 = __expf(tv[1] - tv[0]), e2 = __expf(tv[2] - tv[0]), e3 = __expf(tv[3] - tv[0]); const float inv = 1.0f / (1.0f + e1 + e2 + e3);
            if (lane < 4) { const int e = lane == 0 ? ti[0] : (lane == 1 ? ti[1] : (lane == 2 ? ti[2] : ti[3])); const float gt = (lane == 0 ? 1.0f : (lane == 1 ? e1 : (lane == 2 ? e2 : e3))) * inv;
                const unsigned pos = __hip_atomic_fetch_add(cntg + e, 1u, RLX_AGENT);
                LIST[(size_t)e * T + pos] = t; u32x2 ti2; ti2.x = ((unsigned)e << 16) | pos; ti2.y = __float_as_uint(gt); TOKINFO[(size_t)t * 4 + lane] = ti2; }
        }
    }
}

__device__ __forceinline__ int moe_setup(Frame& F) {
    LAS int* Lcnt = (LAS int*)(F.lds + L_CNT); LAS int* Lbase = (LAS int*)(F.lds + L_BASE); LAS int* Ltile = (LAS int*)(F.lds + L_TILE_E);
    const unsigned* cntg = (const unsigned*)(F.ws + WS_CTL) + CW_CNT;
    if (F.tid < 64) {
        const int e = F.lane & 31; const int c = (int)__hip_atomic_load(cntg + e, RLX_AGENT); const int tl = (c + 255) >> 8;
        int incl = tl;
#pragma unroll
        for (int o = 1; o < 32; o <<= 1) { const int v = __shfl_up(incl, o); if ((F.lane & 31) >= o) incl += v; }
        const int excl = incl - tl;
        if (F.lane < 32) { Lcnt[e] = c; Lbase[e] = excl; if (e == 31) Lbase[32] = incl; for (int i = 0; i < tl; ++i) Ltile[excl + i] = e; }
    }
    LDS_WAIT(); __syncthreads();
    return Lbase[32];
}
__device__ __forceinline__ void moe_gather_table(Frame& F, const Order& S) {
    LAS int* Lcnt = (LAS int*)(F.lds + L_CNT); LAS int* Lbase = (LAS int*)(F.lds + L_BASE); LAS int* Ltile = (LAS int*)(F.lds + L_TILE_E); LAS int* gt = (LAS int*)(F.lds + L_GTAB);
    const int* LIST = (const int*)(F.ws + WS_LIST);
    Unit u;
    for (int i = 0; i < MAXU && S.next(i, u); ++i) {
        if (F.tid < 256) { const int e = Ltile[u.pm]; const int idx = (u.pm - Lbase[e]) * 256 + F.tid; const int tok = idx < Lcnt[e] ? LIST[(size_t)e * T + idx] : 0; gt[i * 256 + F.tid] = tok * 2048; }
    }
    LDS_WAIT(); __syncthreads();
}

__device__ __forceinline__ void combine_phase(Frame& F) {
    const int lane = F.lane, gw = F.vcu * 8 + F.wave, NGW = F.G * 8;
    const float* X1 = (const float*)(F.ws + WS_X1); float* X2 = (float*)(F.ws + WS_X2); const bf16_t* Y = (const bf16_t*)(F.ws + WS_Y); bf16_t* XN = (bf16_t*)(F.ws + WS_XN);
    const u32x2* TOKINFO = (const u32x2*)(F.ws + WS_TOKINFO); const float* g_ple = F.in[15];
    LAS int* Lbase = (LAS int*)(F.lds + L_BASE);
    for (int t = gw; t < T; t += NGW) {
        f32x4 v[4];
#pragma unroll
        for (int j = 0; j < 4; ++j) v[j] = ((const f32x4*)(X1 + (size_t)t * D))[lane + 64 * j];
#pragma unroll
        for (int k = 0; k < 4; ++k) { const u32x2 ti = TOKINFO[(size_t)t * 4 + k]; const int e = (int)(ti.x >> 16), pos = (int)(ti.x & 0xffffu); const float gt = __uint_as_float(ti.y);
            const size_t row = (size_t)Lbase[e] * 256 + pos; const u32x2* yr = (const u32x2*)(Y + row * 1024);
#pragma unroll
            for (int j = 0; j < 4; ++j) { const u32x2 yv = yr[lane + 64 * j]; v[j].x += gt * bflo(yv.x); v[j].y += gt * bfhi(yv.x); v[j].z += gt * bflo(yv.y); v[j].w += gt * bfhi(yv.y); } }
        float s = 0.f;
#pragma unroll
        for (int j = 0; j < 4; ++j) { ((f32x4*)(X2 + (size_t)t * D))[lane + 64 * j] = v[j]; s += (v[j].x * v[j].x + v[j].y * v[j].y) + (v[j].z * v[j].z + v[j].w * v[j].w); }
        const float rstd = 1.f / sqrtf(wave_sum(s) * (1.f / D) + EPS);
        unsigned long long* o8 = (unsigned long long*)(XN + (size_t)t * D) + lane;
#pragma unroll
        for (int j = 0; j < 4; ++j) { const f32x4 gg = ((const f32x4*)g_ple)[lane + 64 * j];
            o8[64 * j] = (unsigned long long)pk2(v[j].x * rstd * gg.x, v[j].y * rstd * gg.y) | ((unsigned long long)pk2(v[j].z * rstd * gg.z, v[j].w * rstd * gg.w) << 32); }
    }
}
__device__ __forceinline__ void final_phase(Frame& F) {
    const int lane = F.lane, gw = F.vcu * 8 + F.wave, NGW = F.G * 8;
    const float* rowss = (const float*)(F.ws + WS_ROWSS); const float* g_final = F.in[18];
    for (int t = gw; t < T; t += NGW) {
        const float rstd = 1.f / sqrtf(rowss[t] * (1.f / D) + EPS);
#pragma unroll
        for (int j = 0; j < 4; ++j) { f32x4* p = (f32x4*)(F.out + (size_t)t * D) + lane + 64 * j; const f32x4 gg = ((const f32x4*)g_final)[lane + 64 * j]; f32x4 v = *p; v = v * rstd * gg; *p = v; }
    }
}

struct Args { const float* in[19]; float* out; unsigned char* ws; int ph_lo, ph_hi; };
__global__ void __launch_bounds__(512, 2) mega_fwd(Args args) {
    extern __shared__ __attribute__((aligned(16))) unsigned char lds_raw[];
    Frame F;
    F.lds = (LAS unsigned char*)lds_raw;
    F.tid = threadIdx.x; F.lane = F.tid & 63; F.wave = __builtin_amdgcn_readfirstlane(F.tid >> 6);
    F.G = gridDim.x; { const int bx = blockIdx.x; F.vcu = (F.G % 8 == 0) ? (bx % 8) * (F.G / 8) + bx / 8 : bx; }
    F.ws = args.ws; F.out = args.out;
#pragma unroll
    for (int i = 0; i < 19; ++i) F.in[i] = args.in[i];
    volatile LAS unsigned* MISC = (volatile LAS unsigned*)(F.lds + L_MISC);
    if (F.tid < 64) MISC[F.tid] = 0u;
    __syncthreads();
    unsigned* ctl = (unsigned*)(F.ws + WS_CTL);
    XcdBarrier bar = xcd_barrier_post(ctl + CW_BAR, MISC + 8);
    const int lo = args.ph_lo, hi = args.ph_hi;
#define IN(k) (lo <= (k) && (k) < hi)
#define SEAM(k) do { if (IN(k) && IN((k) + 1)) xcd_barrier(bar); } while (0)
    LAS unsigned char* ring = F.lds;
#ifndef NO_P0
    if (IN(0)) p0_prologue(F);
#endif
    SEAM(0);
#ifndef NO_P1
    if (IN(1)) {
#ifndef NO_P1A
        { Gemm g{(const bf16_t*)(F.ws + WS_XN), (const bf16_t*)(F.ws + WS_WT_IN), 1024}; Order S; S.init(T / 256, 2048 / 256, F.G, (int)blockIdx.x, nullptr);
          EpiUQKV E{(bf16_t*)(F.ws + WS_UQKV), (size_t)T * 512}; gemm_phase<EpiUQKV, false>(ring, g, S, E, nullptr); }
#endif
#ifndef NO_P1B
        { Gemm g{(const bf16_t*)(F.ws + WS_PB), (const bf16_t*)(F.ws + WS_WT_PP), 256}; Order S; S.init(T / 256, 1024 / 256, F.G, (int)blockIdx.x, nullptr);
          EpiBf16 E{(bf16_t*)(F.ws + WS_PPB), 1024}; gemm_phase<EpiBf16, false>(ring, g, S, E, nullptr); }
#endif
    }
#endif
    SEAM(1);
#ifndef NO_P2
    if (IN(2)) attn_phase(F);
#endif
    SEAM(2);
#ifndef NO_P3
    if (IN(3)) merge_pool_phase(F);
#endif
    SEAM(3);
#ifndef NO_P4
    if (IN(4)) { Gemm g{(const bf16_t*)(F.ws + WS_MIX), (const bf16_t*)(F.ws + WS_WT_OUT), 1024}; Order S; S.init(T / 256, 1024 / 256, F.G, (int)blockIdx.x, nullptr);
        EpiResF32 E{F.in[0], (float*)(F.ws + WS_X1)}; gemm_phase<EpiResF32, false>(ring, g, S, E, nullptr); }
#endif
    SEAM(4);
#ifndef NO_P5
    if (IN(5)) router_phase(F);
#endif
    SEAM(5);
    if (IN(6) || IN(7) || IN(8)) {
        const int ntiles = moe_setup(F);
        const LAS int* Ltile = (const LAS int*)(F.lds + L_TILE_E);
#ifndef NO_P6
        if (IN(6)) { Gemm g{(const bf16_t*)(F.ws + WS_XN), (const bf16_t*)(F.ws + WS_WT_GU), 1024}; Order S; S.init(ntiles, 8, F.G, (int)blockIdx.x, Ltile);
            moe_gather_table(F, S);
            EpiSwiGLU E{(bf16_t*)(F.ws + WS_H), F.in[12]}; gemm_phase<EpiSwiGLU, true>(ring, g, S, E, (const LAS int*)(F.lds + L_GTAB)); }
#endif
        SEAM(6);
#ifndef NO_P7
        if (IN(7)) { Gemm g{(const bf16_t*)(F.ws + WS_H), (const bf16_t*)(F.ws + WS_WT_DN), 1024}; Order S; S.init(ntiles, 4, F.G, (int)blockIdx.x, Ltile);
            EpiDown E{(bf16_t*)(F.ws + WS_Y), F.in[14]}; gemm_phase<EpiDown, false>(ring, g, S, E, nullptr); }
#endif
        SEAM(7);
#ifndef NO_P8
        if (IN(8)) combine_phase(F);
#endif
    } else { SEAM(6); SEAM(7); }
    SEAM(8);
#ifndef NO_P9
    if (IN(9)) { Gemm g{(const bf16_t*)(F.ws + WS_XN), (const bf16_t*)(F.ws + WS_WT_PG), 1024}; Order S; S.init(T / 256, 1024 / 256, F.G, (int)blockIdx.x, nullptr);
        EpiPle E{(const float*)(F.ws + WS_X2), (const bf16_t*)(F.ws + WS_PPB), F.out, (float*)(F.ws + WS_ROWSS)}; gemm_phase<EpiPle, false>(ring, g, S, E, nullptr); }
#endif
    SEAM(9);
#ifndef NO_P10
    if (IN(10)) final_phase(F);
#endif
#undef IN
#undef SEAM
}

static int g_grid = 0;
static bool launch_phases(void* const* d_in, void* d_out, void* d_ws, size_t ws_size, hipStream_t stream, int lo, int hi) {
    if (g_grid == 0) {
        int dev = 0, cus = 0;
        if (hipGetDevice(&dev) != hipSuccess || hipDeviceGetAttribute(&cus, hipDeviceAttributeMultiprocessorCount, dev) != hipSuccess) { g_grid = -1; return false; }
        if (hipFuncSetAttribute((const void*)mega_fwd, hipFuncAttributeMaxDynamicSharedMemorySize, LDS_BYTES) != hipSuccess) { fprintf(stderr, "hipFuncSetAttribute failed\n"); g_grid = -1; return false; }
        int per_cu = 0;
        if (hipOccupancyMaxActiveBlocksPerMultiprocessor(&per_cu, (const void*)mega_fwd, 512, LDS_BYTES) != hipSuccess || per_cu < 1) { fprintf(stderr, "occupancy query: %d\n", per_cu); }
        (void)hipGetLastError();
        if (ws_size < WS_END) { fprintf(stderr, "workspace too small: %zu < %zu\n", ws_size, (size_t)WS_END); g_grid = -1; return false; }
        g_grid = cus;
    }
    if (g_grid < 0) return false;
    Args a{};
    for (int i = 0; i < 19; ++i) a.in[i] = (const float*)d_in[i];
    a.out = (float*)d_out; a.ws = (unsigned char*)d_ws; a.ph_lo = lo; a.ph_hi = hi;
    hipLaunchKernelGGL(mega_fwd, dim3(g_grid), dim3(512), LDS_BYTES, stream, a);
    return true;
}
}
extern "C" void kernel_launch(void* const* d_in, const int* in_sizes, int n_in, void* d_out, int out_size, void* d_ws, size_t ws_size, hipStream_t stream) {
    (void)in_sizes; (void)n_in; (void)out_size;
    if (hipMemsetAsync((char*)d_ws + mk::WS_CTL, 0, mk::CTL_ZERO_BYTES, stream) != hipSuccess) { fprintf(stderr, "memset failed\n"); return; }
    mk::launch_phases(d_in, d_out, d_ws, ws_size, stream, 0, 11);
}
```

```cpp
#include <hip/hip_runtime.h>
#include <cstdio>
#include <cstdint>
#include <cmath>
#define LAS __attribute__((address_space(3)))
#define GAS __attribute__((address_space(1)))
typedef unsigned short bf16_t;
typedef short bf16x8 __attribute__((ext_vector_type(8)));
typedef short s16x4 __attribute__((ext_vector_type(4)));
typedef float f32x4 __attribute__((ext_vector_type(4)));
typedef float f32x16 __attribute__((ext_vector_type(16)));
typedef float f32x2 __attribute__((ext_vector_type(2)));
typedef unsigned u32x4 __attribute__((ext_vector_type(4)));
typedef unsigned u32x2 __attribute__((ext_vector_type(2)));

namespace mk {
constexpr int T = 16384, D = 1024, S = 4096, NE = 32, PLE = 256;
constexpr int NROWS_MAX = 73728;
constexpr float EPS = 1e-6f;
constexpr float LOG2E = 1.4426950408889634f;
constexpr float QSCALE = 0.125f * LOG2E;

__device__ __forceinline__ unsigned cvt_pk_bf16(float lo, float hi) { unsigned r; asm volatile("v_cvt_pk_bf16_f32 %0, %1, %2" : "=v"(r) : "v"(lo), "v"(hi)); return r; }
__device__ __forceinline__ float bf2f(unsigned short b) { return __uint_as_float(((unsigned)b) << 16); }
__device__ __forceinline__ float bflo(unsigned w) { return __uint_as_float(w << 16); }
__device__ __forceinline__ float bfhi(unsigned w) { return __uint_as_float(w & 0xffff0000u); }
__device__ __forceinline__ float wave_sum(float v) {
#pragma unroll
    for (int o = 1; o < 64; o <<= 1) v += __shfl_xor(v, o);
    return v;
}
__device__ __forceinline__ float sigmoidf_fast(float z) { return __builtin_amdgcn_rcpf(1.0f + __builtin_amdgcn_exp2f(-LOG2E * z)); }

constexpr int BM = 256, BK = 64, HALF = 128, HTB = HALF * BK * 2, STAGE_BYTES = 8 * HTB, NXCD = 8, WGM = 8;
__host__ __device__ __forceinline__ int lds_byte(int r, int c) { const int st = (r >> 4) * 2 + (c >> 5), rr = r & 15, cc = c & 31, ob = rr * 64 + cc * 2; return st * 1024 + (ob ^ (((ob >> 9) & 1) << 5)); }
__host__ __device__ __forceinline__ void stage_rc(int b, int& R, int& C) { const int st = b / 1024, sb = b % 1024, swz = sb ^ (((sb >> 9) & 1) << 5); R = (st >> 1) * 16 + swz / 64; C = (st & 1) * 32 + (swz % 64) / 2; }
__host__ __device__ __forceinline__ int perm32(int rho) { const int n = rho >> 4, i = rho & 15; return 8 * (i >> 2) + 4 * n + (i & 3); }

struct Unit { int pm, pn; };
struct Gemm { const bf16_t* A; const bf16_t* Bt; int K; };

struct Order {
    int nM, nN, nwg, G, c; const LAS int* tile_e;
    __device__ __forceinline__ void init(int nM_, int nN_, int G_, int c_, const LAS int* te) { nM = nM_; nN = nN_; nwg = nM * nN; G = G_; c = c_; tile_e = te; }
    __device__ __forceinline__ bool next(int i, Unit& u) const {
        const long L = (long)i * G + c; if (L >= nwg) return false;
        int wgid = (int)L; { const int q = nwg / NXCD, r = nwg % NXCD, xcd = wgid % NXCD, off = wgid / NXCD; wgid = (xcd < r ? xcd * (q + 1) : r * (q + 1) + (xcd - r) * q) + off; }
        const int nig = WGM * nN, gid = wgid / nig, fm = gid * WGM, gsz = (nM - fm) < WGM ? (nM - fm) : WGM;
        u.pm = fm + ((wgid % nig) % gsz); u.pn = (wgid % nig) / gsz; return true;
    }
    __device__ __forceinline__ int b_tile(const Unit& u) const { return tile_e ? tile_e[u.pm] * nN + u.pn : u.pn; }
    __device__ __forceinline__ int expert(const Unit& u) const { return tile_e ? tile_e[u.pm] : 0; }
};

typedef f32x4 Acc[2][2][4][2];

template <class Epi, bool GATHER>
__device__ __forceinline__ void gemm_phase(LAS unsigned char* lds, const Gemm g, const Order& S, const Epi& E, const LAS int* gtab) {
    const int tid = threadIdx.x, wid = __builtin_amdgcn_readfirstlane(tid >> 6), lane = tid & 63, wr = wid >> 2, wc = wid & 3, fr = lane & 15, fq = lane >> 4;
    const int K = g.K, nt = K / BK;
    unsigned voffB[2], vA0[2], vA1[2]; int Rr[2], Cc[2];
#pragma unroll
    for (int i = 0; i < 2; ++i) { int R, C; stage_rc(tid * 16 + i * 8192, R, C); const int Rb = Epi::PERM ? ((R & ~31) + perm32(R & 31)) : R;
        Rr[i] = R; Cc[i] = C; voffB[i] = (unsigned)(Rb * K + C) * 2u;
        if constexpr (!GATHER) { vA0[i] = (unsigned)(R * K + C) * 2u; vA1[i] = vA0[i]; } }
    const size_t kstep = (size_t)(BK * 2);
    const size_t hstep = (size_t)HALF * K * 2;
    const size_t hstepA = GATHER ? 0 : hstep;
    const size_t tstep = 2 * hstep;
    const unsigned ldsw = (unsigned)wid * 1024u;
    const int aoff = lds_byte(wr * 64 + fr, fq * 8), boff = lds_byte(wc * 32 + fr, fq * 8);
#define PG8_SA(b, h) (((b) * 2 + (h)) * HTB)
#define PG8_SB(b, h) ((4 + (b) * 2 + (h)) * HTB)
#define PG8_STAGE(bufoff, gbase, voff) do { _Pragma("unroll") for (int _i = 0; _i < 2; ++_i) \
        __builtin_amdgcn_global_load_lds((const unsigned*)((const char*)(gbase) + (voff)[_i]), (LAS unsigned*)(lds + (bufoff) + ldsw + _i * 8192), 16, 0, 0); } while (0)
#define PG8_LDA(dst, b, h) do { _Pragma("unroll") for (int m = 0; m < 4; ++m) _Pragma("unroll") for (int k = 0; k < 2; ++k) dst[m][k] = *(const LAS bf16x8*)(lds + PG8_SA(b, h) + aoff + m * 2048 + k * 1024); } while (0)
#define PG8_LDB(dst, b, h) do { _Pragma("unroll") for (int n = 0; n < 2; ++n) _Pragma("unroll") for (int k = 0; k < 2; ++k) dst[n][k] = *(const LAS bf16x8*)(lds + PG8_SB(b, h) + boff + n * 2048 + k * 1024); } while (0)
#define PG8_MMA(ai, bj, At, Bt) do { __builtin_amdgcn_s_setprio(1); _Pragma("unroll") for (int m = 0; m < 4; ++m) _Pragma("unroll") for (int n = 0; n < 2; ++n) _Pragma("unroll") for (int k = 0; k < 2; ++k) \
        acc[ai][bj][m][n] = __builtin_amdgcn_mfma_f32_16x16x32_bf16(Bt[n][k], At[m][k], acc[ai][bj][m][n], 0, 0, 0); __builtin_amdgcn_s_setprio(0); } while (0)
#define PG8_WAIT_V(n) asm volatile("s_waitcnt vmcnt(" #n ")" ::: "memory")
#define PG8_WAIT_L(n) asm volatile("s_waitcnt lgkmcnt(" #n ")" ::: "memory")
#define PG8_BAR __builtin_amdgcn_s_barrier()
#define PG8_SCHED __builtin_amdgcn_sched_barrier(0)
#define PG8_GLOAD(uidx) do { _Pragma("unroll") for (int _i = 0; _i < 2; ++_i) { vA0[_i] = (unsigned)gtab[(uidx) * 256 + Rr[_i]] + (unsigned)Cc[_i] * 2u; vA1[_i] = (unsigned)gtab[(uidx) * 256 + 128 + Rr[_i]] + (unsigned)Cc[_i] * 2u; } } while (0)
    Unit cur, nxt; int ui = 0;
    if (!S.next(0, cur)) return;
    Acc acc;
#pragma unroll
    for (int a = 0; a < 2; ++a)
#pragma unroll
        for (int b = 0; b < 2; ++b)
#pragma unroll
            for (int m = 0; m < 4; ++m)
#pragma unroll
                for (int n = 0; n < 2; ++n) acc[a][b][m][n] = (f32x4){0.f, 0.f, 0.f, 0.f};
    bf16x8 At[4][2], B0[2][2], B1[2][2];
    if constexpr (GATHER) PG8_GLOAD(0);
    const char* cA = (const char*)g.A + (GATHER ? (size_t)0 : (size_t)cur.pm * tstep); const char* cB = (const char*)g.Bt + (size_t)S.b_tile(cur) * tstep;
    PG8_STAGE(PG8_SB(0, 0), cB, voffB); PG8_STAGE(PG8_SB(0, 1), cB + hstep, voffB); PG8_STAGE(PG8_SA(0, 0), cA, vA0); PG8_STAGE(PG8_SA(0, 1), cA + hstepA, vA1);
    if (wr == 1) PG8_BAR;
    PG8_WAIT_V(2); PG8_BAR;
    PG8_STAGE(PG8_SB(1, 0), cB + kstep, voffB); PG8_STAGE(PG8_SA(1, 0), cA + kstep, vA0); PG8_STAGE(PG8_SB(1, 1), cB + hstep + kstep, voffB);
    PG8_WAIT_V(6); PG8_BAR;
    for (;;) {
        const bool has_next = S.next(ui + 1, nxt);
        const char* nA = has_next ? (const char*)g.A + (GATHER ? (size_t)0 : (size_t)nxt.pm * tstep) : cA; const char* nB = has_next ? (const char*)g.Bt + (size_t)S.b_tile(nxt) * tstep : cB;
#pragma unroll 1
        for (int t = 0; t < nt; t += 2) {
            const bool last = (t == nt - 2);
            const char* a1 = cA + (size_t)(t + 1) * kstep;
            const char* a2 = last ? nA : cA + (size_t)(t + 2) * kstep; const char* b2 = last ? nB : cB + (size_t)(t + 2) * kstep;
            const char* a3 = a2 + kstep; const char* b3 = b2 + kstep;
            PG8_LDB(B0, 0, 0); PG8_LDB(B1, 0, 1); PG8_SCHED; PG8_LDA(At, 0, 0); PG8_STAGE(PG8_SA(1, 1), a1 + hstepA, vA1);
            PG8_WAIT_V(8); PG8_WAIT_L(0); PG8_BAR; PG8_MMA(0, 0, At, B0); PG8_MMA(0, 1, At, B1); PG8_BAR; PG8_SCHED;
            if constexpr (GATHER) { if (last && has_next) { PG8_GLOAD(ui + 1); } }
            PG8_LDA(At, 0, 1); PG8_STAGE(PG8_SB(0, 0), b2, voffB); PG8_STAGE(PG8_SB(0, 1), b2 + hstep, voffB); PG8_STAGE(PG8_SA(0, 0), a2, vA0);
            PG8_WAIT_V(8); PG8_WAIT_L(0); PG8_BAR; PG8_MMA(1, 0, At, B0); PG8_MMA(1, 1, At, B1); PG8_BAR; PG8_SCHED;
            PG8_LDB(B0, 1, 0); PG8_LDB(B1, 1, 1); PG8_SCHED; PG8_LDA(At, 1, 0); PG8_STAGE(PG8_SA(0, 1), a2 + hstepA, vA1);
            PG8_WAIT_V(8); PG8_WAIT_L(0); PG8_BAR; PG8_MMA(0, 0, At, B0); PG8_MMA(0, 1, At, B1); PG8_BAR; PG8_SCHED;
            PG8_LDA(At, 1, 1); PG8_STAGE(PG8_SB(1, 0), b3, voffB); PG8_STAGE(PG8_SB(1, 1), b3 + hstep, voffB); PG8_STAGE(PG8_SA(1, 0), a3, vA0);
            PG8_WAIT_V(8); PG8_WAIT_L(0); PG8_BAR; PG8_MMA(1, 0, At, B0); PG8_MMA(1, 1, At, B1); PG8_BAR; PG8_SCHED;
        }
        if (wr == 0) PG8_BAR;
        E(acc, cur, S, wr, wc, fr, fq);
        if (!has_next) break;
#pragma unroll
        for (int a = 0; a < 2; ++a)
#pragma unroll
            for (int b = 0; b < 2; ++b)
#pragma unroll
                for (int m = 0; m < 4; ++m)
#pragma unroll
                    for (int n = 0; n < 2; ++n) acc[a][b][m][n] = (f32x4){0.f, 0.f, 0.f, 0.f};
        cur = nxt; cA = nA; cB = nB; ++ui;
        if (wr == 1) PG8_BAR;
    }
    PG8_WAIT_V(0);
    PG8_BAR;
#undef PG8_SA
#undef PG8_SB
#undef PG8_STAGE
#undef PG8_LDA
#undef PG8_LDB
#undef PG8_MMA
#undef PG8_WAIT_V
#undef PG8_WAIT_L
#undef PG8_BAR
#undef PG8_SCHED
#undef PG8_GLOAD
}

struct EpiUQKV {
    static constexpr bool PERM = true;
    bf16_t* base; size_t stride;
    __device__ __forceinline__ void operator()(const Acc& acc, const Unit& u, const Order&, int wr, int wc, int fr, int fq) const {
        bf16_t* O = base + (size_t)(u.pn >> 1) * stride;
        const int row0 = u.pm * BM + wr * 64 + fr, col0 = (u.pn & 1) * 256 + wc * 32 + 8 * fq;
#pragma unroll
        for (int ai = 0; ai < 2; ++ai)
#pragma unroll
            for (int m = 0; m < 4; ++m) { bf16_t* rowp = O + (size_t)(row0 + ai * HALF + m * 16) * 512 + col0;
#pragma unroll
                for (int bj = 0; bj < 2; ++bj) { const f32x4 v0 = acc[ai][bj][m][0], v1 = acc[ai][bj][m][1];
                    u32x4 w; w.x = cvt_pk_bf16(v0[0], v0[1]); w.y = cvt_pk_bf16(v0[2], v0[3]); w.z = cvt_pk_bf16(v1[0], v1[1]); w.w = cvt_pk_bf16(v1[2], v1[3]);
                    *(u32x4*)(rowp + bj * HALF) = w; } }
    }
};
struct EpiBf16 {
    static constexpr bool PERM = true;
    bf16_t* O; int ldc;
    __device__ __forceinline__ void operator()(const Acc& acc, const Unit& u, const Order&, int wr, int wc, int fr, int fq) const {
        const int row0 = u.pm * BM + wr * 64 + fr, col0 = u.pn * BM + wc * 32 + 8 * fq;
#pragma unroll
        for (int ai = 0; ai < 2; ++ai)
#pragma unroll
            for (int m = 0; m < 4; ++m) { bf16_t* rowp = O + (size_t)(row0 + ai * HALF + m * 16) * ldc + col0;
#pragma unroll
                for (int bj = 0; bj < 2; ++bj) { const f32x4 v0 = acc[ai][bj][m][0], v1 = acc[ai][bj][m][1];
                    u32x4 w; w.x = cvt_pk_bf16(v0[0], v0[1]); w.y = cvt_pk_bf16(v0[2], v0[3]); w.z = cvt_pk_bf16(v1[0], v1[1]); w.w = cvt_pk_bf16(v1[2], v1[3]);
                    *(u32x4*)(rowp + bj * HALF) = w; } }
    }
};
struct EpiResF32 {
    static constexpr bool PERM = false;
    const float* base; float* out;
    __device__ __forceinline__ void operator()(const Acc& acc, const Unit& u, const Order&, int wr, int wc, int fr, int fq) const {
        const int row0 = u.pm * BM + wr * 64 + fr, col0 = u.pn * BM + wc * 32 + 4 * fq;
#pragma unroll
        for (int ai = 0; ai < 2; ++ai)
#pragma unroll
            for (int m = 0; m < 4; ++m) { const size_t off = (size_t)(row0 + ai * HALF + m * 16) * D + col0;
#pragma unroll
                for (int bj = 0; bj < 2; ++bj)
#pragma unroll
                    for (int n = 0; n < 2; ++n) { const f32x4 b = *(const f32x4*)(base + off + bj * HALF + n * 16); *(f32x4*)(out + off + bj * HALF + n * 16) = b + acc[ai][bj][m][n]; } }
    }
};
struct EpiSwiGLU {
    static constexpr bool PERM = true;
    bf16_t* H; const float* bgu;
    __device__ __forceinline__ void operator()(const Acc& acc, const Unit& u, const Order& S, int wr, int wc, int fr, int fq) const {
        const int e = S.expert(u);
        const int row0 = u.pm * BM + wr * 64 + fr, j0 = u.pn * 128 + wc * 32 + 8 * fq;
        const float* bg = bgu + (size_t)e * 2048 + j0; const float* bu = bg + 1024;
        const f32x4 bg0 = *(const f32x4*)bg, bg1 = *(const f32x4*)(bg + 4), bu0 = *(const f32x4*)bu, bu1 = *(const f32x4*)(bu + 4);
#pragma unroll
        for (int ai = 0; ai < 2; ++ai)
#pragma unroll
            for (int m = 0; m < 4; ++m) {
                float hv[8];
#pragma unroll
                for (int n = 0; n < 2; ++n) { const f32x4 gq = acc[ai][0][m][n] + (n ? bg1 : bg0), uq = acc[ai][1][m][n] + (n ? bu1 : bu0);
#pragma unroll
                    for (int x = 0; x < 4; ++x) { const float gg = fminf(gq[x], 7.0f), uu = fminf(fmaxf(uq[x], -7.0f), 7.0f);
                        hv[n * 4 + x] = (uu + 1.0f) * gg * __builtin_amdgcn_rcpf(1.0f + __builtin_amdgcn_exp2f(-1.702f * LOG2E * gg)); } }
                u32x4 w; w.x = cvt_pk_bf16(hv[0], hv[1]); w.y = cvt_pk_bf16(hv[2], hv[3]); w.z = cvt_pk_bf16(hv[4], hv[5]); w.w = cvt_pk_bf16(hv[6], hv[7]);
                *(u32x4*)(H + (size_t)(row0 + ai * HALF + m * 16) * 1024 + j0) = w; }
    }
};
struct EpiDown {
    static constexpr bool PERM = true;
    bf16_t* Y; const float* bdn;
    __device__ __forceinline__ void operator()(const Acc& acc, const Unit& u, const Order& S, int wr, int wc, int fr, int fq) const {
        const int e = S.expert(u);
        const int row0 = u.pm * BM + wr * 64 + fr, col0 = u.pn * BM + wc * 32 + 8 * fq;
        const float* bp = bdn + (size_t)e * 1024 + col0;
#pragma unroll
        for (int bj = 0; bj < 2; ++bj) { const f32x4 b0 = *(const f32x4*)(bp + bj * HALF), b1 = *(const f32x4*)(bp + bj * HALF + 4);
#pragma unroll
            for (int ai = 0; ai < 2; ++ai)
#pragma unroll
                for (int m = 0; m < 4; ++m) { const f32x4 v0 = acc[ai][bj][m][0] + b0, v1 = acc[ai][bj][m][1] + b1;
                    u32x4 w; w.x = cvt_pk_bf16(v0[0], v0[1]); w.y = cvt_pk_bf16(v0[2], v0[3]); w.z = cvt_pk_bf16(v1[0], v1[1]); w.w = cvt_pk_bf16(v1[2], v1[3]);
                    *(u32x4*)(Y + (size_t)(row0 + ai * HALF + m * 16) * 1024 + col0 + bj * HALF) = w; } }
    }
};
struct EpiPle {
    static constexpr bool PERM = false;
    const float* x2; const bf16_t* pp; float* out; float* rowss;
    __device__ __forceinline__ void operator()(const Acc& acc, const Unit& u, const Order&, int wr, int wc, int fr, int fq) const {
        const int row0 = u.pm * BM + wr * 64 + fr, col0 = u.pn * BM + wc * 32 + 4 * fq;
#pragma unroll
        for (int ai = 0; ai < 2; ++ai)
#pragma unroll
            for (int m = 0; m < 4; ++m) { const int row = row0 + ai * HALF + m * 16; const size_t off = (size_t)row * D + col0; float ss = 0.f;
#pragma unroll
                for (int bj = 0; bj < 2; ++bj)
#pragma unroll
                    for (int n = 0; n < 2; ++n) { const size_t o2 = off + bj * HALF + n * 16; const f32x4 xb = *(const f32x4*)(x2 + o2); const u32x2 pw = *(const u32x2*)(pp + o2);
                        const f32x4 a = acc[ai][bj][m][n]; f32x4 r;
                        r[0] = xb[0] + bflo(pw.x) * sigmoidf_fast(a[0]); r[1] = xb[1] + bfhi(pw.x) * sigmoidf_fast(a[1]);
                        r[2] = xb[2] + bflo(pw.y) * sigmoidf_fast(a[2]); r[3] = xb[3] + bfhi(pw.y) * sigmoidf_fast(a[3]);
                        ss += (r[0] * r[0] + r[1] * r[1]) + (r[2] * r[2] + r[3] * r[3]);
                        *(f32x4*)(out + o2) = r; }
                ss += __shfl_xor(ss, 16); ss += __shfl_xor(ss, 32);
                if (fq == 0) atomicAdd(rowss + row, ss); }
    }
};
}
namespace mk {
constexpr size_t MiB = 1u << 20;
constexpr size_t WS_CTL = 0, CTL_ZERO_BYTES = 1 * MiB;
constexpr int CW_TMO = 0, CW_CNT = 16384, CW_BAR = 4096;
constexpr size_t WS_ROWSS = 512 * 1024;
constexpr size_t WS_BIAS = 1 * MiB;
constexpr size_t WS_WPT = 1 * MiB + 64 * 1024;
constexpr size_t WS_WT_PP = 2 * MiB;
constexpr size_t WS_WT_IN = 4 * MiB;
constexpr size_t WS_WT_OUT = 8 * MiB;
constexpr size_t WS_WT_PG = 10 * MiB;
constexpr size_t WS_LIST = 12 * MiB;
constexpr size_t WS_TOKINFO = 14 * MiB;
constexpr size_t WS_LSE = 15 * MiB;
constexpr size_t WS_PB = 17 * MiB;
constexpr size_t WS_WT_GU = 32 * MiB;
constexpr size_t WS_WT_DN = 160 * MiB;
constexpr size_t WS_XN = 224 * MiB;
constexpr size_t WS_UQKV = 256 * MiB;
constexpr size_t WS_OB = 320 * MiB;
constexpr size_t WS_MIX = 368 * MiB;
constexpr size_t WS_PPB = 400 * MiB;
constexpr size_t WS_X1 = 432 * MiB;
constexpr size_t WS_X2 = 496 * MiB;
constexpr size_t WS_H = 560 * MiB;
constexpr size_t WS_Y = 704 * MiB;
constexpr size_t WS_END = 848 * MiB;

constexpr int RING_BYTES = 131072;
constexpr int L_MISC = RING_BYTES;
constexpr int L_CNT = L_MISC + 256;
constexpr int L_BASE = L_CNT + 128;
constexpr int L_TILE_E = L_BASE + 256;
constexpr int L_GTAB = L_TILE_E + 1280;
constexpr int MAXU = 12;
constexpr int LDS_BYTES = 163840;
static_assert(L_GTAB + MAXU * 1024 <= LDS_BYTES, "LDS map");

typedef GAS unsigned gu32;
#define RLX_AGENT __ATOMIC_RELAXED, __HIP_MEMORY_SCOPE_AGENT
#define LDS_WAIT() asm volatile("s_waitcnt lgkmcnt(0)" ::: "memory")
#define VM_WAIT() asm volatile("s_waitcnt vmcnt(0)" ::: "memory")

#define XB_TMO      128
#define XB_XCNT(j)  (256  + 64 * (j))
#define XB_XSUB(j)  (1280 + 64 * (j))
#define XB_XGEN(j)  (2304 + 64 * (j))
#define XB_TOP      3328
#define XB_TOPGEN   3392
#define XCD_BAR_WORDS 3456
#define XB_SPIN_CAP (1u << 18)
__device__ __forceinline__ unsigned xb_ld(unsigned* p)              { return __hip_atomic_load(p, __ATOMIC_RELAXED, __HIP_MEMORY_SCOPE_AGENT); }
__device__ __forceinline__ unsigned xb_add(unsigned* p, unsigned v) { return __hip_atomic_fetch_add(p, v, __ATOMIC_RELAXED, __HIP_MEMORY_SCOPE_AGENT); }
__device__ __forceinline__ unsigned xb_xcc_id() { return (unsigned)__builtin_amdgcn_s_getreg((3 << 11) | 20) & 0xFu; }
#define XB_SPIN(cond, bar) do { unsigned _sp = 0; while (cond) { __builtin_amdgcn_s_sleep(1); \
    if ((++_sp & 255u) == 0u) { if (xb_ld(&(bar)[XB_TMO])) break; if (_sp > XB_SPIN_CAP) { atomicAdd(&(bar)[XB_TMO], 1u); break; } } } } while (0)
struct XcdBarrier { unsigned* bar; unsigned x; volatile LAS unsigned* st; };
__device__ __forceinline__ XcdBarrier xcd_barrier_post(unsigned* bar, volatile LAS unsigned* st) {
    XcdBarrier b; b.bar = bar; b.x = xb_xcc_id(); b.st = st;
    if (threadIdx.x == 0) (void)xb_add(&bar[XB_XCNT(b.x)], 1u);
    return b;
}
__device__ __forceinline__ void xcd_barrier_complete(unsigned* bar, unsigned x, unsigned& nloc, unsigned& nx) {
    const unsigned G = gridDim.x * gridDim.y * gridDim.z;
    unsigned sum, cnt, mine, sp = 0u;
    for (;;) {
        sum = 0u; cnt = 0u; mine = 0u;
#pragma unroll
        for (unsigned j = 0; j < 16; ++j) { const unsigned c = xb_ld(&bar[XB_XCNT(j)]); sum += c; cnt += (c > 0u) ? 1u : 0u; mine = (j == x) ? c : mine; }
        if (sum == G) break;
        __builtin_amdgcn_s_sleep(1);
        if ((++sp & 255u) == 0u) { if (xb_ld(&bar[XB_TMO])) break; if (sp > XB_SPIN_CAP) { atomicAdd(&bar[XB_TMO], 1u); break; } }
    }
    nloc = mine > 0u ? mine : 1u; nx = cnt > 0u ? cnt : 1u;
}
__device__ __forceinline__ void xcd_barrier(const XcdBarrier& b) {
    asm volatile("s_waitcnt vmcnt(0)" ::: "memory");
    __syncthreads();
    if (threadIdx.x == 0) {
        unsigned* bar = b.bar;
        __builtin_amdgcn_s_waitcnt(0);
        unsigned nloc = b.st[0], nx = b.st[1];
        if (nloc == 0u) { xcd_barrier_complete(bar, b.x, nloc, nx); b.st[0] = nloc; b.st[1] = nx; }
        const unsigned old = xb_add(&bar[XB_XSUB(b.x)], 1u);
        const unsigned gen = old / nloc;
        if (old + 1u == (gen + 1u) * nloc) {
            __builtin_amdgcn_fence(__ATOMIC_RELEASE, "agent");
            asm volatile("s_waitcnt vmcnt(0)" ::: "memory");
            const unsigned og = xb_add(&bar[XB_TOP], 1u);
            const unsigned tg = og / nx;
            if (og + 1u == (tg + 1u) * nx) xb_add(&bar[XB_TOPGEN], 1u);
            else XB_SPIN(xb_ld(&bar[XB_TOPGEN]) == tg, bar);
            __builtin_amdgcn_fence(__ATOMIC_ACQUIRE, "agent");
            xb_add(&bar[XB_XGEN(b.x)], 1u);
            asm volatile("s_waitcnt vmcnt(0)" ::: "memory");
        } else {
            XB_SPIN(xb_ld(&bar[XB_XGEN(b.x)]) == gen, bar);
            __builtin_amdgcn_fence(__ATOMIC_ACQUIRE, "agent");
            asm volatile("s_waitcnt vmcnt(0)" ::: "memory");
        }
    }
    __syncthreads();
}

struct Frame {
    LAS unsigned char* lds;
    int tid, lane, wave, vcu, G;
    unsigned char* ws;
    const float* in[19];
    float* out;
};
__device__ __forceinline__ unsigned f2bf(float f) { unsigned u = __builtin_bit_cast(unsigned, f); return (u + 0x7fffu + ((u >> 16) & 1u)) >> 16; }
__device__ __forceinline__ unsigned pk2(float lo, float hi) { return f2bf(lo) | (f2bf(hi) << 16); }

__device__ __forceinline__ void p0_transpose_item(const float* W, int K, int N, bf16_t* WT, int k0, int n0, int drow0, LAS float* scr, int lane, float scale = 1.0f) {
#pragma unroll 8
    for (int i = 0; i < 32; ++i) { const int kk = 2 * i + (lane >> 5); scr[kk * 33 + (lane & 31)] = W[(size_t)(k0 + kk) * N + n0 + (lane & 31)] * scale; }
    LDS_WAIT(); asm volatile("" ::: "memory");
    const int c = lane & 7;
#pragma unroll
    for (int j = 0; j < 4; ++j) { const int n = (lane >> 3) + 8 * j; const LAS float* s = scr + (8 * c) * 33 + n;
        u32x4 o; o.x = pk2(s[0 * 33], s[1 * 33]); o.y = pk2(s[2 * 33], s[3 * 33]); o.z = pk2(s[4 * 33], s[5 * 33]); o.w = pk2(s[6 * 33], s[7 * 33]);
        *(GAS u32x4*)(WT + (size_t)(drow0 + n) * K + k0 + 8 * c) = o; }
    LDS_WAIT(); asm volatile("" ::: "memory");
}
__device__ __forceinline__ int t5_bucket(int dist) {
    if (dist < 16) return dist;
    const float n = (float)dist;
    int large = 16 + (int)(logf(n / 16.0f) / logf(128.0f) * 16.0f);
    return large < 31 ? large : 31;
}
__device__ __forceinline__ void rms_row_to_bf16(const float* xrow, const float* g, bf16_t* orow, int lane) {
    const f32x4* xr = (const f32x4*)xrow + lane; const f32x4* gr = (const f32x4*)g + lane;
    f32x4 v[4]; float s = 0.f;
#pragma unroll
    for (int j = 0; j < 4; ++j) { v[j] = xr[64 * j]; s += (v[j].x * v[j].x + v[j].y * v[j].y) + (v[j].z * v[j].z + v[j].w * v[j].w); }
    const float rstd = 1.f / sqrtf(wave_sum(s) * (1.f / D) + EPS);
    unsigned long long* o8 = (unsigned long long*)orow + lane;
#pragma unroll
    for (int j = 0; j < 4; ++j) { const f32x4 gg = gr[64 * j];
        o8[64 * j] = (unsigned long long)pk2(v[j].x * rstd * gg.x, v[j].y * rstd * gg.y) | ((unsigned long long)pk2(v[j].z * rstd * gg.z, v[j].w * rstd * gg.w) << 32); }
}
__device__ __forceinline__ void p0_prologue(Frame& F) {
    LAS float* scr = (LAS float*)(F.lds + F.wave * 16384);
    const int gw = F.vcu * 8 + F.wave, NGW = F.G * 8, lane = F.lane;
    const float* w_in = F.in[3]; const float* w_pool = F.in[4]; const float* w_out = F.in[7]; const float* w_gu = F.in[11]; const float* w_dn = F.in[13];
    const float* w_pg = F.in[16]; const float* w_pp = F.in[17];
    bf16_t* WT_IN = (bf16_t*)(F.ws + WS_WT_IN); bf16_t* WT_OUT = (bf16_t*)(F.ws + WS_WT_OUT); bf16_t* WT_PG = (bf16_t*)(F.ws + WS_WT_PG); bf16_t* WT_PP = (bf16_t*)(F.ws + WS_WT_PP);
    bf16_t* WPT = (bf16_t*)(F.ws + WS_WPT); bf16_t* WT_GU = (bf16_t*)(F.ws + WS_WT_GU); bf16_t* WT_DN = (bf16_t*)(F.ws + WS_WT_DN);
    constexpr int I_IN = 16 * 64, I_OUT = 16 * 32, I_PG = 16 * 32, I_PP = 4 * 32, I_POOL = 4 * 2 * 4, I_GU = 32 * 16 * 64, I_DN = 32 * 16 * 32;
    constexpr int NITEMS = I_IN + I_OUT + I_PG + I_PP + I_POOL + I_GU + I_DN;
    for (int it = gw; it < NITEMS; it += NGW) {
        int r = it;
        if (r < I_GU) { const int e = r / 1024, q = r % 1024, kb = q / 64, nb = q % 64, n0 = nb * 32;
            const int half = n0 >> 10, j = n0 & 1023, pn = j >> 7, jj = j & 127;
            p0_transpose_item(w_gu + (size_t)e * 1024 * 2048, 1024, 2048, WT_GU + (size_t)e * 2048 * 1024, kb * 64, n0, pn * 256 + half * 128 + jj, scr, lane); continue; } r -= I_GU;
        if (r < I_DN) { const int e = r / 512, q = r % 512, kb = q / 32, nb = q % 32;
            p0_transpose_item(w_dn + (size_t)e * 1024 * 1024, 1024, 1024, WT_DN + (size_t)e * 1024 * 1024, kb * 64, nb * 32, nb * 32, scr, lane); continue; } r -= I_DN;
        if (r < I_IN) { const int kb = r / 64, nb = r % 64; p0_transpose_item(w_in, 1024, 2048, WT_IN, kb * 64, nb * 32, nb * 32, scr, lane, (nb >= 16 && nb < 32) ? QSCALE : 1.0f); continue; } r -= I_IN;
        if (r < I_OUT) { const int kb = r / 32, nb = r % 32; p0_transpose_item(w_out, 1024, 1024, WT_OUT, kb * 64, nb * 32, nb * 32, scr, lane); continue; } r -= I_OUT;
        if (r < I_PG) { const int kb = r / 32, nb = r % 32; p0_transpose_item(w_pg, 1024, 1024, WT_PG, kb * 64, nb * 32, nb * 32, scr, lane); continue; } r -= I_PG;
        if (r < I_PP) { const int kb = r / 32, nb = r % 32; p0_transpose_item(w_pp, 256, 1024, WT_PP, kb * 64, nb * 32, nb * 32, scr, lane); continue; } r -= I_PP;
        { const int g = r / 8, q = r % 8, kb = q / 4, nb = q % 4; p0_transpose_item(w_pool + (size_t)g * 128 * 128, 128, 128, WPT + (size_t)g * 128 * 128, kb * 64, nb * 32, nb * 32, scr, lane); }
    }
    bf16_t* XN = (bf16_t*)(F.ws + WS_XN);
    for (int m = gw; m < T; m += NGW) rms_row_to_bf16(F.in[0] + (size_t)m * D, F.in[2], XN + (size_t)m * D, lane);
    bf16_t* PB = (bf16_t*)(F.ws + WS_PB);
    for (int m = gw; m < T; m += NGW) { const f32x4 v = ((const f32x4*)(F.in[1] + (size_t)m * PLE))[lane];
        ((unsigned long long*)(PB + (size_t)m * PLE))[lane] = (unsigned long long)pk2(v.x, v.y) | ((unsigned long long)pk2(v.z, v.w) << 32); }
    if (blockIdx.x == 0) { float* BT = (float*)(F.ws + WS_BIAS);
        for (int i = F.tid; i < 3 * 8 * 132; i += 512) { const int br = i / (8 * 132), h = (i / 132) % 8, rel = i % 132; const int dil = br == 0 ? 1 : (br == 1 ? 4 : 16);
            BT[i] = rel <= 128 ? F.in[6][t5_bucket(rel * dil) * 8 + h] * LOG2E : 0.f; } }
}

__device__ __forceinline__ int fK(int row) { return (row >> 1) & 7; }
__device__ __forceinline__ int fV(int row) { return ((row >> 1) & 1) << 2; }
__device__ __forceinline__ int crow(int r, int hi) { return (r & 3) + 8 * (r >> 2) + 4 * hi; }
__device__ __forceinline__ s16x4 tr_read(LAS const unsigned char* p) { typedef short v4i16_t __attribute__((ext_vector_type(4)));
    return __builtin_bit_cast(s16x4, __builtin_amdgcn_ds_read_tr16_b64_v4i16((LAS v4i16_t*)p)); }
__device__ __forceinline__ void attn_phase(Frame& F) {
    const int lane = F.lane, w = F.wave, r32 = lane & 31, hi = lane >> 5;
    const bf16_t* QB = (const bf16_t*)(F.ws + WS_UQKV) + (size_t)1 * T * 512; const bf16_t* KB = QB + (size_t)T * 512; const bf16_t* VB = KB + (size_t)T * 512;
    bf16_t* OB = (bf16_t*)(F.ws + WS_OB); float* LSE = (float*)(F.ws + WS_LSE); const float* BT = (const float*)(F.ws + WS_BIAS);
    LAS unsigned char* Kl = F.lds; LAS unsigned char* Vl = F.lds + 49152;
    constexpr int NITEM = 4 * 8 * 3 * 16;
    const int ipc = (NITEM + F.G - 1) / F.G;
    for (int it = F.vcu * ipc; it < NITEM && it < (F.vcu + 1) * ipc; ++it) {
        const int bh = it / 48, sub = it % 48, br = sub / 16, q16 = sub % 16;
        const int b = bh >> 3, h = bh & 7;
        const int dsh = br * 2, d = 1 << dsh;
        const int nblk = 16 >> dsh;
        const int r = q16 / nblk, m = q16 % nblk;
        const int lbase = 256 * m - 128;
        const size_t rowb = (size_t)b * S;
#pragma unroll
        for (int pi = 0; pi < 6; ++pi) { const int piece = w + 8 * pi, row = piece * 8 + (lane >> 3), cp = lane & 7;
            int lp = lbase + row; lp = lp < 0 ? 0 : lp;
            const size_t tok = rowb + (size_t)lp * d + r;
            const bf16_t* ks = KB + tok * 512 + h * 64 + ((cp ^ fK(row)) << 3);
            const bf16_t* vs = VB + tok * 512 + h * 64 + ((cp ^ fV(row)) << 3);
            __builtin_amdgcn_global_load_lds((const unsigned*)ks, (LAS unsigned*)(Kl + piece * 1024), 16, 0, 0);
            __builtin_amdgcn_global_load_lds((const unsigned*)vs, (LAS unsigned*)(Vl + piece * 1024), 16, 0, 0); }
        const int lq = 256 * m + 32 * w + r32;
        const size_t qtok = rowb + (size_t)lq * d + r;
        bf16x8 qf[4];
#pragma unroll
        for (int d0 = 0; d0 < 4; ++d0) qf[d0] = *(const bf16x8*)(QB + qtok * 512 + h * 64 + d0 * 16 + hi * 8);
        LAS float* btl = (LAS float*)(F.lds + 98304);
        if (F.tid < 132) btl[F.tid] = BT[(br * 8 + h) * 132 + F.tid];
        VM_WAIT(); LDS_WAIT(); __syncthreads();
        f32x16 p[5];
        int r32v = r32, hiv = hi; asm volatile("" : "+v"(r32v), "+v"(hiv));
        float mx = -3.0e38f;
#pragma unroll
        for (int jt = 0; jt < 5; ++jt) {
            const int krow = 32 * w + 32 * jt + r32;
            f32x16 acc = {};
#pragma unroll
            for (int d0 = 0; d0 < 4; ++d0) { const bf16x8 kf = *(const LAS bf16x8*)(Kl + krow * 128 + (((2 * d0 + hi) ^ fK(krow)) << 4));
                acc = __builtin_amdgcn_mfma_f32_32x32x16_bf16(kf, qf[d0], acc, 0, 0, 0); }
#pragma unroll
            for (int rr = 0; rr < 16; ++rr) { const int kk = crow(rr, hiv); const int rel = 128 + r32v - 32 * jt - kk; const int lp = lbase + 32 * w + 32 * jt + kk;
                const bool ok = (rel >= 0) && (rel <= 128) && (lp >= 0);
                const float sv = ok ? acc[rr] + btl[ok ? rel : 0] : -3.0e38f;
                acc[rr] = sv; mx = fmaxf(mx, sv); }
            p[jt] = acc;
            __builtin_amdgcn_sched_barrier(0);
        }
        { const float o = __shfl_xor(mx, 32); mx = fmaxf(mx, o); }
        float ls = 0.f;
#pragma unroll
        for (int jt = 0; jt < 5; ++jt)
#pragma unroll
            for (int rr = 0; rr < 16; ++rr) { const float e = __builtin_amdgcn_exp2f(p[jt][rr] - mx); p[jt][rr] = e; ls += e; }
        ls += __shfl_xor(ls, 32);
        __builtin_amdgcn_sched_barrier(0);
        f32x16 o[2]; o[0] = (f32x16){}; o[1] = (f32x16){};
#pragma unroll
        for (int jt = 0; jt < 5; ++jt)
#pragma unroll
            for (int s = 0; s < 2; ++s) {
                u32x4 pw; pw.x = cvt_pk_bf16(p[jt][8 * s + 0], p[jt][8 * s + 1]); pw.y = cvt_pk_bf16(p[jt][8 * s + 2], p[jt][8 * s + 3]);
                pw.z = cvt_pk_bf16(p[jt][8 * s + 4], p[jt][8 * s + 5]); pw.w = cvt_pk_bf16(p[jt][8 * s + 6], p[jt][8 * s + 7]);
                const bf16x8 pf = __builtin_bit_cast(bf16x8, pw);
                const int g = lane >> 4, qq = (lane & 15) >> 2, pp = lane & 3;
                const int key0 = 32 * w + 32 * jt + 16 * s + 4 * (g >> 1);
#pragma unroll
                for (int d0 = 0; d0 < 2; ++d0) {
                    const int dcol = 32 * d0 + 16 * (g & 1) + 4 * pp;
                    const int ra = key0 + qq, rb = key0 + 8 + qq;
                    const s16x4 lo = tr_read(Vl + ra * 128 + (((dcol >> 3) ^ fV(ra)) << 4) + (dcol & 7) * 2);
                    const s16x4 hh = tr_read(Vl + rb * 128 + (((dcol >> 3) ^ fV(rb)) << 4) + (dcol & 7) * 2);
                    const bf16x8 vf = (bf16x8){lo[0], lo[1], lo[2], lo[3], hh[0], hh[1], hh[2], hh[3]};
                    o[d0] = __builtin_amdgcn_mfma_f32_32x32x16_bf16(vf, pf, o[d0], 0, 0, 0);
                }
                __builtin_amdgcn_sched_barrier(0);
            }
        const float inv = 1.0f / ls;
        bf16_t* op = OB + ((size_t)br * T + qtok) * 512 + h * 64;
#pragma unroll
        for (int d0 = 0; d0 < 2; ++d0)
#pragma unroll
            for (int g4 = 0; g4 < 4; ++g4) { u32x2 wv; wv.x = cvt_pk_bf16(o[d0][4 * g4 + 0] * inv, o[d0][4 * g4 + 1] * inv); wv.y = cvt_pk_bf16(o[d0][4 * g4 + 2] * inv, o[d0][4 * g4 + 3] * inv);
                *(u32x2*)(op + 32 * d0 + 8 * g4 + 4 * hi) = wv; }
        if (hi == 0) LSE[((size_t)br * T + qtok) * 8 + h] = mx + __builtin_amdgcn_logf(ls);
        LDS_WAIT(); __syncthreads();
    }
}

__device__ __forceinline__ void merge_pool_phase(Frame& F) {
    const int gw = F.vcu * 8 + F.wave, NGW = F.G * 8, lane = F.lane;
    const bf16_t* OB = (const bf16_t*)(F.ws + WS_OB); const float* LSE = (const float*)(F.ws + WS_LSE); bf16_t* MIX = (bf16_t*)(F.ws + WS_MIX);
    for (int t = gw; t < T; t += NGW) {
        const int h = lane >> 3;
        const float l0 = LSE[((size_t)0 * T + t) * 8 + h], l1 = LSE[((size_t)1 * T + t) * 8 + h], l2 = LSE[((size_t)2 * T + t) * 8 + h];
        const float mm = fmaxf(l0, fmaxf(l1, l2));
        float w0 = __builtin_amdgcn_exp2f(l0 - mm), w1 = __builtin_amdgcn_exp2f(l1 - mm), w2 = __builtin_amdgcn_exp2f(l2 - mm);
        const float inv = 1.0f / (w0 + w1 + w2); w0 *= inv; w1 *= inv; w2 *= inv;
        const u32x4 a = *(const u32x4*)(OB + ((size_t)0 * T + t) * 512 + lane * 8), bq = *(const u32x4*)(OB + ((size_t)1 * T + t) * 512 + lane * 8), c = *(const u32x4*)(OB + ((size_t)2 * T + t) * 512 + lane * 8);
        u32x4 o;
#pragma unroll
        for (int i = 0; i < 4; ++i) { const float lo = w0 * bflo(a[i]) + w1 * bflo(bq[i]) + w2 * bflo(c[i]), hi = w0 * bfhi(a[i]) + w1 * bfhi(bq[i]) + w2 * bfhi(c[i]); o[i] = cvt_pk_bf16(lo, hi); }
        *(u32x4*)(MIX + (size_t)t * 1024 + 512 + lane * 8) = o;
    }
    const bf16_t* UB = (const bf16_t*)(F.ws + WS_UQKV); const bf16_t* WPT = (const bf16_t*)(F.ws + WS_WPT); const float* pscale = F.in[5];
    const int r32 = lane & 31, hi = lane >> 5;
    for (int it = gw; it < (T / 32) * 4; it += NGW) {
        const int g = it & 3, t0 = (it >> 2) * 32, tok = t0 + r32, tin = tok & (S - 1), wdw = 2 << g;
        const int cnt = (tin + 1 < wdw) ? tin + 1 : wdw; const float rc = 1.0f / (float)cnt;
        bf16x8 bfrag[8];
#pragma unroll
        for (int s = 0; s < 8; ++s) {
            const bf16_t* up = UB + (size_t)tok * 512 + g * 128 + 16 * s + 8 * hi;
            float sum[8]; const u32x4 cur = *(const u32x4*)up;
#pragma unroll
            for (int i = 0; i < 4; ++i) { sum[2 * i] = bflo(cur[i]); sum[2 * i + 1] = bfhi(cur[i]); }
            for (int j = 1; j < cnt; ++j) { const u32x4 v = *(const u32x4*)(up - (size_t)j * 512);
#pragma unroll
                for (int i = 0; i < 4; ++i) { sum[2 * i] += bflo(v[i]); sum[2 * i + 1] += bfhi(v[i]); } }
            u32x4 pw;
#pragma unroll
            for (int i = 0; i < 4; ++i) pw[i] = cvt_pk_bf16(sum[2 * i] * rc - bflo(cur[i]), sum[2 * i + 1] * rc - bfhi(cur[i]));
            bfrag[s] = __builtin_bit_cast(bf16x8, pw);
        }
#pragma unroll
        for (int db = 0; db < 4; ++db) {
            f32x16 acc = {};
#pragma unroll
            for (int s = 0; s < 8; ++s) { const bf16x8 af = *(const bf16x8*)(WPT + ((size_t)g * 128 + 32 * db + r32) * 128 + 16 * s + 8 * hi);
                acc = __builtin_amdgcn_mfma_f32_32x32x16_bf16(af, bfrag[s], acc, 0, 0, 0); }
#pragma unroll
            for (int g4 = 0; g4 < 4; ++g4) { const int dd = g * 128 + 32 * db + 8 * g4 + 4 * hi; const f32x4 sc = *(const f32x4*)(pscale + dd);
                u32x2 wv; wv.x = cvt_pk_bf16(acc[4 * g4 + 0] * sc[0], acc[4 * g4 + 1] * sc[1]); wv.y = cvt_pk_bf16(acc[4 * g4 + 2] * sc[2], acc[4 * g4 + 3] * sc[3]);
                *(u32x2*)(MIX + (size_t)tok * 1024 + dd) = wv; }
        }
    }
}
}
namespace mk {
constexpr int CNT_STRIDE = 64;
__device__ __forceinline__ void router_phase(Frame& F, bool dummy = false) {
    const int lane = F.lane, gw = F.vcu * 8 + F.wave, NGW = F.G * 8;
    const float* X1 = (const float*)(F.ws + WS_X1); const float* g_ffn = F.in[8]; const float* w_r = F.in[9]; const float* b_r = F.in[10];
    bf16_t* XN = (bf16_t*)(F.ws + WS_XN); int* LIST = (int*)(F.ws + WS_LIST); u32x2* TOKINFO = (u32x2*)(F.ws + WS_TOKINFO);
    unsigned* cntg = (unsigned*)(F.ws + WS_CTL) + CW_CNT;
    if (dummy) { cntg += 32 * CNT_STRIDE; LIST = (int*)(F.ws + WS_H); TOKINFO = (u32x2*)(F.ws + WS_H + 4 * MiB); }
    LAS f32x4* wl = (LAS f32x4*)F.lds;
    LAS int* lcnt = (LAS int*)(F.lds + L_GTAB);
    LAS int* sel_t = lcnt + 64;
    LAS unsigned* sel_e = (LAS unsigned*)(lcnt + 192);
    LAS float* sel_g = (LAS float*)(lcnt + 704);
    for (int i = F.tid; i < 1024 * 8; i += 512) { const int k = i >> 3, c = i & 7; f32x4 v = *(const f32x4*)(w_r + (size_t)k * 32 + c * 4); v = v * g_ffn[k]; wl[k * 8 + (c ^ ((k >> 1) & 7))] = v; }
    if (F.tid < 32) lcnt[F.tid] = 0;
    LDS_WAIT(); __syncthreads();
    const float bias_e = b_r[(lane >> 1) & 31];
    int li = F.wave * 16;
    for (int t0 = gw * 2; t0 < T; t0 += NGW * 2) {
        float xa[16], xb[16]; float sa = 0.f, sb = 0.f;
#pragma unroll
        for (int i = 0; i < 16; ++i) { xa[i] = X1[(size_t)t0 * D + lane + 64 * i]; xb[i] = X1[(size_t)(t0 + 1) * D + lane + 64 * i]; sa += xa[i] * xa[i]; sb += xb[i] * xb[i]; }
        const float ra = 1.f / sqrtf(wave_sum(sa) * (1.f / D) + EPS), rb = 1.f / sqrtf(wave_sum(sb) * (1.f / D) + EPS);
        float aa[32], ab[32];
#pragma unroll
        for (int e = 0; e < 32; ++e) { aa[e] = 0.f; ab[e] = 0.f; }
#pragma unroll
        for (int i = 0; i < 16; ++i) { const int k = lane + 64 * i; const float va = xa[i], vb = xb[i];
#pragma unroll
            for (int c = 0; c < 8; ++c) { const f32x4 wv = wl[k * 8 + (c ^ ((k >> 1) & 7))];
#pragma unroll
                for (int x = 0; x < 4; ++x) { aa[4 * c + x] = fmaf(va, wv[x], aa[4 * c + x]); ab[4 * c + x] = fmaf(vb, wv[x], ab[4 * c + x]); } }
            asm volatile("" ::: "memory"); }
#pragma unroll
        for (int i = 0; i < 16; ++i) { const int k = lane + 64 * i; const float gk = g_ffn[k];
            XN[(size_t)t0 * D + k] = (bf16_t)f2bf(xa[i] * ra * gk); XN[(size_t)(t0 + 1) * D + k] = (bf16_t)f2bf(xb[i] * rb * gk); }
#define RSTEP(N, MASK) \
        _Pragma("unroll") for (int i = 0; i < N; ++i) { const bool up = (lane & MASK) != 0; \
            { const float keep = up ? aa[i + N] : aa[i], send = up ? aa[i] : aa[i + N]; aa[i] = keep + __shfl_xor(send, MASK); } \
            { const float keep = up ? ab[i + N] : ab[i], send = up ? ab[i] : ab[i + N]; ab[i] = keep + __shfl_xor(send, MASK); } }
        RSTEP(16, 32) RSTEP(8, 16) RSTEP(4, 8) RSTEP(2, 4) RSTEP(1, 2)
#undef RSTEP
        float la = aa[0] + __shfl_xor(aa[0], 1), lb = ab[0] + __shfl_xor(ab[0], 1);
        la = la * ra + bias_e; lb = lb * rb + bias_e;
        const int my_e = (lane >> 1) & 31;
#pragma unroll
        for (int row = 0; row < 2; ++row) {
            float v = row ? lb : la; const int t = t0 + row;
            float tv[4]; int ti[4];
#pragma unroll
            for (int k = 0; k < 4; ++k) {
                float bv = v; int bi = my_e;
#pragma unroll
                for (int o = 2; o < 64; o <<= 1) { const float ov = __shfl_xor(bv, o); const int oi = __shfl_xor(bi, o); if (ov > bv || (ov == bv && oi < bi)) { bv = ov; bi = oi; } }
                tv[k] = bv; ti[k] = bi; if (my_e == bi) v = -INFINITY;
            }
            const float e1 = __expf(tv[1] - tv[0]), e2 = __expf(tv[2] - tv[0]), e3 = __expf(tv[3] - tv[0]); const float inv = 1.0f / (1.0f + e1 + e2 + e3);
            if (lane < 4) { const int e = lane == 0 ? ti[0] : (lane == 1 ? ti[1] : (lane == 2 ? ti[2] : ti[3])); const float gt = (lane == 0 ? 1.0f : (lane == 1 ? e1 : (lane == 2 ? e2 : e3))) * inv;
                const int rank = __hip_atomic_fetch_add(lcnt + e, 1, __ATOMIC_RELAXED, __HIP_MEMORY_SCOPE_WORKGROUP);
                sel_e[li * 4 + lane] = (unsigned)e | ((unsigned)rank << 8); sel_g[li * 4 + lane] = gt; if (lane == 0) sel_t[li] = t; }
            ++li;
        }
    }
    const int nloc = li - F.wave * 16;
    LDS_WAIT(); __syncthreads();
    if (F.tid < 32) { const int c = lcnt[F.tid]; const unsigned base = c ? __hip_atomic_fetch_add(cntg + F.tid * CNT_STRIDE, (unsigned)c, RLX_AGENT) : 0u; lcnt[F.tid] = (int)base; }
    LDS_WAIT(); __syncthreads();
    { const int w = F.tid >> 6, r = (F.tid & 63) >> 2, k = F.tid & 3;
      if (r < nloc) { const int l2 = w * 16 + r; const unsigned ev = sel_e[l2 * 4 + k]; const int e = (int)(ev & 0xffu); const unsigned pos = (unsigned)lcnt[e] + (ev >> 8); const int t = sel_t[l2];
          LIST[(size_t)e * T + pos] = t; u32x2 ti2; ti2.x = ((unsigned)e << 16) | pos; ti2.y = __float_as_uint(sel_g[l2 * 4 + k]); TOKINFO[(size_t)t * 4 + k] = ti2; } }
    LDS_WAIT(); __syncthreads();
}

__device__ __forceinline__ int moe_setup(Frame& F) {
    LAS int* Lcnt = (LAS int*)(F.lds + L_CNT); LAS int* Lbase = (LAS int*)(F.lds + L_BASE); LAS int* Ltile = (LAS int*)(F.lds + L_TILE_E);
    const unsigned* cntg = (const unsigned*)(F.ws + WS_CTL) + CW_CNT;
    if (F.tid < 64) {
        const int e = F.lane & 31; const int c = (int)__hip_atomic_load(cntg + e * CNT_STRIDE, RLX_AGENT); const int tl = (c + 255) >> 8;
        int incl = tl;
#pragma unroll
        for (int o = 1; o < 32; o <<= 1) { const int v = __shfl_up(incl, o); if ((F.lane & 31) >= o) incl += v; }
        const int excl = incl - tl;
        if (F.lane < 32) { Lcnt[e] = c; Lbase[e] = excl; if (e == 31) Lbase[32] = incl; for (int i = 0; i < tl; ++i) Ltile[excl + i] = e; }
    }
    LDS_WAIT(); __syncthreads();
    return Lbase[32];
}
__device__ __forceinline__ void moe_gather_table(Frame& F, const Order& S) {
    LAS int* Lcnt = (LAS int*)(F.lds + L_CNT); LAS int* Lbase = (LAS int*)(F.lds + L_BASE); LAS int* Ltile = (LAS int*)(F.lds + L_TILE_E); LAS int* gt = (LAS int*)(F.lds + L_GTAB);
    const int* LIST = (const int*)(F.ws + WS_LIST);
    Unit u;
    for (int i = 0; i < MAXU && S.next(i, u); ++i) {
        if (F.tid < 256) { const int e = Ltile[u.pm]; const int idx = (u.pm - Lbase[e]) * 256 + F.tid; const int tok = idx < Lcnt[e] ? LIST[(size_t)e * T + idx] : 0; gt[i * 256 + F.tid] = tok * 2048; }
    }
    LDS_WAIT(); __syncthreads();
}

__device__ __forceinline__ void combine_phase(Frame& F) {
    const int lane = F.lane, gw = F.vcu * 8 + F.wave, NGW = F.G * 8;
    const float* X1 = (const float*)(F.ws + WS_X1); float* X2 = (float*)(F.ws + WS_X2); const bf16_t* Y = (const bf16_t*)(F.ws + WS_Y); bf16_t* XN = (bf16_t*)(F.ws + WS_XN);
    const u32x2* TOKINFO = (const u32x2*)(F.ws + WS_TOKINFO); const float* g_ple = F.in[15];
    LAS int* Lbase = (LAS int*)(F.lds + L_BASE);
    for (int t = gw; t < T; t += NGW) {
        f32x4 v[4];
#pragma unroll
        for (int j = 0; j < 4; ++j) v[j] = ((const f32x4*)(X1 + (size_t)t * D))[lane + 64 * j];
#pragma unroll
        for (int k = 0; k < 4; ++k) { const u32x2 ti = TOKINFO[(size_t)t * 4 + k]; const int e = (int)(ti.x >> 16), pos = (int)(ti.x & 0xffffu); const float gt = __uint_as_float(ti.y);
            const size_t row = (size_t)Lbase[e] * 256 + pos; const u32x2* yr = (const u32x2*)(Y + row * 1024);
#pragma unroll
            for (int j = 0; j < 4; ++j) { const u32x2 yv = yr[lane + 64 * j]; v[j].x += gt * bflo(yv.x); v[j].y += gt * bfhi(yv.x); v[j].z += gt * bflo(yv.y); v[j].w += gt * bfhi(yv.y); } }
        float s = 0.f;
#pragma unroll
        for (int j = 0; j < 4; ++j) { ((f32x4*)(X2 + (size_t)t * D))[lane + 64 * j] = v[j]; s += (v[j].x * v[j].x + v[j].y * v[j].y) + (v[j].z * v[j].z + v[j].w * v[j].w); }
        const float rstd = 1.f / sqrtf(wave_sum(s) * (1.f / D) + EPS);
        unsigned long long* o8 = (unsigned long long*)(XN + (size_t)t * D) + lane;
#pragma unroll
        for (int j = 0; j < 4; ++j) { const f32x4 gg = ((const f32x4*)g_ple)[lane + 64 * j];
            o8[64 * j] = (unsigned long long)pk2(v[j].x * rstd * gg.x, v[j].y * rstd * gg.y) | ((unsigned long long)pk2(v[j].z * rstd * gg.z, v[j].w * rstd * gg.w) << 32); }
    }
}
__device__ __forceinline__ void final_phase(Frame& F) {
    const int lane = F.lane, gw = F.vcu * 8 + F.wave, NGW = F.G * 8;
    const float* rowss = (const float*)(F.ws + WS_ROWSS); const float* g_final = F.in[18];
    for (int t = gw; t < T; t += NGW) {
        const float rstd = 1.f / sqrtf(rowss[t] * (1.f / D) + EPS);
#pragma unroll
        for (int j = 0; j < 4; ++j) { f32x4* p = (f32x4*)(F.out + (size_t)t * D) + lane + 64 * j; const f32x4 gg = ((const f32x4*)g_final)[lane + 64 * j]; f32x4 v = *p; v = v * rstd * gg; *p = v; }
    }
}

#ifndef DUP
#define DUP (-1)
#endif
struct Args { const float* in[19]; float* out; unsigned char* ws; int ph_lo, ph_hi; };
__global__ void __launch_bounds__(512, 2) mega_fwd(Args args) {
    extern __shared__ __attribute__((aligned(16))) unsigned char lds_raw[];
    Frame F;
    F.lds = (LAS unsigned char*)lds_raw;
    F.tid = threadIdx.x; F.lane = F.tid & 63; F.wave = __builtin_amdgcn_readfirstlane(F.tid >> 6);
    F.G = gridDim.x; { const int bx = blockIdx.x; F.vcu = (F.G % 8 == 0) ? (bx % 8) * (F.G / 8) + bx / 8 : bx; }
    F.ws = args.ws; F.out = args.out;
#pragma unroll
    for (int i = 0; i < 19; ++i) F.in[i] = args.in[i];
    volatile LAS unsigned* MISC = (volatile LAS unsigned*)(F.lds + L_MISC);
    if (F.tid < 64) MISC[F.tid] = 0u;
    __syncthreads();
    unsigned* ctl = (unsigned*)(F.ws + WS_CTL);
    XcdBarrier bar = xcd_barrier_post(ctl + CW_BAR, MISC + 8);
    const int lo = args.ph_lo, hi = args.ph_hi;
#define IN(k) (lo <= (k) && (k) < hi)
#define SEAM(k) do { if (IN(k) && IN((k) + 1)) { xcd_barrier(bar); if (DUP == 20) xcd_barrier(bar); } } while (0)
    LAS unsigned char* ring = F.lds;
#define RUN(k, BODY) do { if (IN(k)) { BODY if (DUP == (k)) { BODY } } } while (0)
#define P1_BODY \
        { Gemm g{(const bf16_t*)(F.ws + WS_XN), (const bf16_t*)(F.ws + WS_WT_IN), 1024}; Order S; S.init(T / 256, 2048 / 256, F.G, (int)blockIdx.x, nullptr); \
          EpiUQKV E{(bf16_t*)(F.ws + WS_UQKV), (size_t)T * 512}; gemm_phase<EpiUQKV, false>(ring, g, S, E, nullptr); } \
        { Gemm g{(const bf16_t*)(F.ws + WS_PB), (const bf16_t*)(F.ws + WS_WT_PP), 256}; Order S; S.init(T / 256, 1024 / 256, F.G, (int)blockIdx.x, nullptr); \
          EpiBf16 E{(bf16_t*)(F.ws + WS_PPB), 1024}; gemm_phase<EpiBf16, false>(ring, g, S, E, nullptr); }
#define P4_BODY \
        { Gemm g{(const bf16_t*)(F.ws + WS_MIX), (const bf16_t*)(F.ws + WS_WT_OUT), 1024}; Order S; S.init(T / 256, 1024 / 256, F.G, (int)blockIdx.x, nullptr); \
          EpiResF32 E{F.in[0], (float*)(F.ws + WS_X1)}; gemm_phase<EpiResF32, false>(ring, g, S, E, nullptr); }
#define P6_BODY \
        { Gemm g{(const bf16_t*)(F.ws + WS_XN), (const bf16_t*)(F.ws + WS_WT_GU), 1024}; Order S; S.init(ntiles, 8, F.G, (int)blockIdx.x, Ltile); \
          moe_gather_table(F, S); \
          EpiSwiGLU E{(bf16_t*)(F.ws + WS_H), F.in[12]}; gemm_phase<EpiSwiGLU, true>(ring, g, S, E, (const LAS int*)(F.lds + L_GTAB)); }
#define P7_BODY \
        { Gemm g{(const bf16_t*)(F.ws + WS_H), (const bf16_t*)(F.ws + WS_WT_DN), 1024}; Order S; S.init(ntiles, 4, F.G, (int)blockIdx.x, Ltile); \
          EpiDown E{(bf16_t*)(F.ws + WS_Y), F.in[14]}; gemm_phase<EpiDown, false>(ring, g, S, E, nullptr); }
#define P9_BODY \
        { Gemm g{(const bf16_t*)(F.ws + WS_XN), (const bf16_t*)(F.ws + WS_WT_PG), 1024}; Order S; S.init(T / 256, 1024 / 256, F.G, (int)blockIdx.x, nullptr); \
          EpiPle E{(const float*)(F.ws + WS_X2), (const bf16_t*)(F.ws + WS_PPB), F.out, (float*)(F.ws + WS_ROWSS)}; gemm_phase<EpiPle, false>(ring, g, S, E, nullptr); }
    RUN(0, p0_prologue(F););
    SEAM(0);
    RUN(1, P1_BODY);
    SEAM(1);
    RUN(2, attn_phase(F););
    SEAM(2);
    RUN(3, merge_pool_phase(F););
    SEAM(3);
    RUN(4, P4_BODY);
    SEAM(4);
    if (IN(5)) { router_phase(F); if (DUP == 5) router_phase(F, true); }
    SEAM(5);
    if (IN(6) || IN(7) || IN(8)) {
        const int ntiles = moe_setup(F);
        const LAS int* Ltile = (const LAS int*)(F.lds + L_TILE_E);
        RUN(6, P6_BODY);
        SEAM(6);
        RUN(7, P7_BODY);
        SEAM(7);
        RUN(8, combine_phase(F););
    }
    SEAM(8);
    if (IN(9)) { P9_BODY if (DUP == 9) { Gemm g{(const bf16_t*)(F.ws + WS_XN), (const bf16_t*)(F.ws + WS_WT_PG), 1024}; Order S; S.init(T / 256, 1024 / 256, F.G, (int)blockIdx.x, nullptr); EpiPle E{(const float*)(F.ws + WS_X2), (const bf16_t*)(F.ws + WS_PPB), F.out, (float*)(F.ws + WS_H)}; gemm_phase<EpiPle, false>(ring, g, S, E, nullptr); } }
    SEAM(9);
    if (IN(10)) final_phase(F);
#undef RUN
#undef IN
#undef SEAM
}

static int g_grid = 0;
static bool launch_phases(void* const* d_in, void* d_out, void* d_ws, size_t ws_size, hipStream_t stream, int lo, int hi) {
    if (g_grid == 0) {
        int dev = 0, cus = 0;
        if (hipGetDevice(&dev) != hipSuccess || hipDeviceGetAttribute(&cus, hipDeviceAttributeMultiprocessorCount, dev) != hipSuccess) { g_grid = -1; return false; }
        if (hipFuncSetAttribute((const void*)mega_fwd, hipFuncAttributeMaxDynamicSharedMemorySize, LDS_BYTES) != hipSuccess) { fprintf(stderr, "hipFuncSetAttribute failed\n"); g_grid = -1; return false; }
        int per_cu = 0;
        if (hipOccupancyMaxActiveBlocksPerMultiprocessor(&per_cu, (const void*)mega_fwd, 512, LDS_BYTES) != hipSuccess || per_cu < 1) { fprintf(stderr, "occupancy query: %d\n", per_cu); }
        (void)hipGetLastError();
        if (ws_size < WS_END) { fprintf(stderr, "workspace too small: %zu < %zu\n", ws_size, (size_t)WS_END); g_grid = -1; return false; }
        g_grid = cus;
    }
    if (g_grid < 0) return false;
    Args a{};
    for (int i = 0; i < 19; ++i) a.in[i] = (const float*)d_in[i];
    a.out = (float*)d_out; a.ws = (unsigned char*)d_ws; a.ph_lo = lo; a.ph_hi = hi;
    hipLaunchKernelGGL(mega_fwd, dim3(g_grid), dim3(512), LDS_BYTES, stream, a);
    return true;
}
}
extern "C" void kernel_launch(void* const* d_in, const int* in_sizes, int n_in, void* d_out, int out_size, void* d_ws, size_t ws_size, hipStream_t stream) {
    (void)in_sizes; (void)n_in; (void)out_size;
    if (hipMemsetAsync((char*)d_ws + mk::WS_CTL, 0, mk::CTL_ZERO_BYTES, stream) != hipSuccess) { fprintf(stderr, "memset failed\n"); return; }
    mk::launch_phases(d_in, d_out, d_ws, ws_size, stream, 0, 11);
}
```

```cpp
#include <hip/hip_runtime.h>
#include <cstdio>
#include <cstdint>
#include <cmath>
#define LAS __attribute__((address_space(3)))
#define GAS __attribute__((address_space(1)))
typedef unsigned short bf16_t;
typedef short bf16x8 __attribute__((ext_vector_type(8)));
typedef short s16x4 __attribute__((ext_vector_type(4)));
typedef float f32x4 __attribute__((ext_vector_type(4)));
typedef float f32x16 __attribute__((ext_vector_type(16)));
typedef float f32x2 __attribute__((ext_vector_type(2)));
typedef unsigned u32x4 __attribute__((ext_vector_type(4)));
typedef unsigned u32x2 __attribute__((ext_vector_type(2)));

namespace mk {
constexpr int T = 16384, D = 1024, S = 4096, NE = 32, PLE = 256;
constexpr int NROWS_MAX = 73728;
constexpr float EPS = 1e-6f;
constexpr float LOG2E = 1.4426950408889634f;
constexpr float QSCALE = 0.125f * LOG2E;

__device__ __forceinline__ unsigned cvt_pk_bf16(float lo, float hi) { unsigned r; asm volatile("v_cvt_pk_bf16_f32 %0, %1, %2" : "=v"(r) : "v"(lo), "v"(hi)); return r; }
__device__ __forceinline__ float bf2f(unsigned short b) { return __uint_as_float(((unsigned)b) << 16); }
__device__ __forceinline__ float bflo(unsigned w) { return __uint_as_float(w << 16); }
__device__ __forceinline__ float bfhi(unsigned w) { return __uint_as_float(w & 0xffff0000u); }
__device__ __forceinline__ float wave_sum(float v) {
#pragma unroll
    for (int o = 1; o < 64; o <<= 1) v += __shfl_xor(v, o);
    return v;
}
__device__ __forceinline__ float sigmoidf_fast(float z) { return __builtin_amdgcn_rcpf(1.0f + __builtin_amdgcn_exp2f(-LOG2E * z)); }

constexpr int BM = 256, BK = 64, HALF = 128, HTB = HALF * BK * 2, STAGE_BYTES = 8 * HTB, NXCD = 8, WGM = 8;
__host__ __device__ __forceinline__ int lds_byte(int r, int c) { const int st = (r >> 4) * 2 + (c >> 5), rr = r & 15, cc = c & 31, ob = rr * 64 + cc * 2; return st * 1024 + (ob ^ (((ob >> 9) & 1) << 5)); }
__host__ __device__ __forceinline__ void stage_rc(int b, int& R, int& C) { const int st = b / 1024, sb = b % 1024, swz = sb ^ (((sb >> 9) & 1) << 5); R = (st >> 1) * 16 + swz / 64; C = (st & 1) * 32 + (swz % 64) / 2; }
__host__ __device__ __forceinline__ int perm32(int rho) { const int n = rho >> 4, i = rho & 15; return 8 * (i >> 2) + 4 * n + (i & 3); }

typedef int v8i32 __attribute__((ext_vector_type(8)));
__device__ __forceinline__ v8i32 cat8(bf16x8 lo, bf16x8 hi) { const u32x4 a = __builtin_bit_cast(u32x4, lo), b = __builtin_bit_cast(u32x4, hi);
    return (v8i32){(int)a.x, (int)a.y, (int)a.z, (int)a.w, (int)b.x, (int)b.y, (int)b.z, (int)b.w}; }
__device__ __forceinline__ unsigned pk_fp8x4(float a, float b, float c, float d) { int r = 0; r = __builtin_amdgcn_cvt_pk_fp8_f32(a, b, r, false); r = __builtin_amdgcn_cvt_pk_fp8_f32(c, d, r, true); return (unsigned)r; }
constexpr float WSCALE = 32.0f, WSCALE_INV = 1.0f / 32.0f;
struct Unit { int pm, pn; };
struct Gemm { const bf16_t* A; const bf16_t* Bt; int K; };

struct Order {
    int nM, nN, nwg, G, c; const LAS int* tile_e;
    __device__ __forceinline__ void init(int nM_, int nN_, int G_, int c_, const LAS int* te) { nM = nM_; nN = nN_; nwg = nM * nN; G = G_; c = c_; tile_e = te; }
    __device__ __forceinline__ bool next(int i, Unit& u) const {
        const long L = (long)i * G + c; if (L >= nwg) return false;
        int wgid = (int)L; { const int q = nwg / NXCD, r = nwg % NXCD, xcd = wgid % NXCD, off = wgid / NXCD; wgid = (xcd < r ? xcd * (q + 1) : r * (q + 1) + (xcd - r) * q) + off; }
        const int nig = WGM * nN, gid = wgid / nig, fm = gid * WGM, gsz = (nM - fm) < WGM ? (nM - fm) : WGM;
        u.pm = fm + ((wgid % nig) % gsz); u.pn = (wgid % nig) / gsz; return true;
    }
    __device__ __forceinline__ int b_tile(const Unit& u) const { return tile_e ? __builtin_amdgcn_readfirstlane(tile_e[u.pm]) * nN + u.pn : u.pn; }
    __device__ __forceinline__ int expert(const Unit& u) const { return tile_e ? __builtin_amdgcn_readfirstlane(tile_e[u.pm]) : 0; }
};

typedef f32x4 Acc[2][2][4][2];

template <class Epi, bool GATHER, bool FP8 = false>
__device__ __forceinline__ void gemm_phase(LAS unsigned char* lds, const Gemm g, const Order& S, const Epi& E, const LAS int* gtab) {
    const int tid = threadIdx.x, wid = __builtin_amdgcn_readfirstlane(tid >> 6), lane = tid & 63, wr = wid >> 2, wc = wid & 3, fr = lane & 15, fq = lane >> 4;
    const int K = g.K, nt = K / BK;
    unsigned voffB[2], vA0[2], vA1[2]; int Rr[2], Cc[2];
#pragma unroll
    for (int i = 0; i < 2; ++i) { int R, C; stage_rc(tid * 16 + i * 8192, R, C); const int Rb = Epi::PERM ? ((R & ~31) + perm32(R & 31)) : R;
        Rr[i] = R; Cc[i] = C; voffB[i] = (unsigned)(Rb * K + C) * 2u;
        if constexpr (!GATHER) { vA0[i] = (unsigned)(R * K + C) * 2u; vA1[i] = vA0[i]; } }
    const size_t kstep = (size_t)(BK * 2);
    const size_t hstep = (size_t)HALF * K * 2;
    const size_t hstepA = GATHER ? 0 : hstep;
    const size_t tstep = 2 * hstep;
    const unsigned ldsw = (unsigned)wid * 1024u;
    const int aoff = lds_byte(wr * 64 + fr, fq * 8), boff = lds_byte(wc * 32 + fr, fq * 8);
#define PG8_SA(b, h) (((b) * 2 + (h)) * HTB)
#define PG8_SB(b, h) ((4 + (b) * 2 + (h)) * HTB)
#define PG8_STAGE(bufoff, gbase, voff) do { _Pragma("unroll") for (int _i = 0; _i < 2; ++_i) \
        __builtin_amdgcn_global_load_lds((const unsigned*)((const char*)(gbase) + (voff)[_i]), (LAS unsigned*)(lds + (bufoff) + ldsw + _i * 8192), 16, 0, 0); } while (0)
#define PG8_LD8(p) ({ typedef int v4i32_ __attribute__((ext_vector_type(4))); const v4i32_ lo_ = *(const LAS v4i32_*)(p), hi_ = *(const LAS v4i32_*)((p) + 1024); __builtin_shufflevector(lo_, hi_, 0, 1, 2, 3, 4, 5, 6, 7); })
#define PG8_LDA(dst, b, h) do { if constexpr (FP8) { _Pragma("unroll") for (int m = 0; m < 4; ++m) dst##8[m] = PG8_LD8(lds + PG8_SA(b, h) + aoff + m * 2048); } \
        else { _Pragma("unroll") for (int m = 0; m < 4; ++m) _Pragma("unroll") for (int k = 0; k < 2; ++k) dst[m][k] = *(const LAS bf16x8*)(lds + PG8_SA(b, h) + aoff + m * 2048 + k * 1024); } } while (0)
#define PG8_LDB(dst, b, h) do { if constexpr (FP8) { _Pragma("unroll") for (int n = 0; n < 2; ++n) dst##8[n] = PG8_LD8(lds + PG8_SB(b, h) + boff + n * 2048); } \
        else { _Pragma("unroll") for (int n = 0; n < 2; ++n) _Pragma("unroll") for (int k = 0; k < 2; ++k) dst[n][k] = *(const LAS bf16x8*)(lds + PG8_SB(b, h) + boff + n * 2048 + k * 1024); } } while (0)
#define PG8_MMA(ai, bj, At, Bt) do { __builtin_amdgcn_s_setprio(1); _Pragma("unroll") for (int m = 0; m < 4; ++m) _Pragma("unroll") for (int n = 0; n < 2; ++n) { \
        if constexpr (FP8) { asm volatile("v_mfma_f32_16x16x128_f8f6f4 %0, %1, %2, %0" : "+v"(acc[ai][bj][m][n]) : "v"(Bt##8[n]), "v"(At##8[m])); } \
        else { _Pragma("unroll") for (int k = 0; k < 2; ++k) acc[ai][bj][m][n] = __builtin_amdgcn_mfma_f32_16x16x32_bf16(Bt[n][k], At[m][k], acc[ai][bj][m][n], 0, 0, 0); } } \
        __builtin_amdgcn_s_setprio(0); } while (0)
#define PG8_WAIT_V(n) asm volatile("s_waitcnt vmcnt(" #n ")" ::: "memory")
#define PG8_WAIT_L(n) asm volatile("s_waitcnt lgkmcnt(" #n ")" ::: "memory")
#define PG8_BAR __builtin_amdgcn_s_barrier()
#define PG8_SCHED __builtin_amdgcn_sched_barrier(0)
#define PG8_GLOAD(uidx) do { _Pragma("unroll") for (int _i = 0; _i < 2; ++_i) { vA0[_i] = (unsigned)gtab[(uidx) * 256 + Rr[_i]] + (unsigned)Cc[_i] * 2u; vA1[_i] = (unsigned)gtab[(uidx) * 256 + 128 + Rr[_i]] + (unsigned)Cc[_i] * 2u; } } while (0)
    Unit cur, nxt; int ui = 0;
    if (!S.next(0, cur)) return;
    Acc acc;
#pragma unroll
    for (int a = 0; a < 2; ++a)
#pragma unroll
        for (int b = 0; b < 2; ++b)
#pragma unroll
            for (int m = 0; m < 4; ++m)
#pragma unroll
                for (int n = 0; n < 2; ++n) acc[a][b][m][n] = (f32x4){0.f, 0.f, 0.f, 0.f};
    bf16x8 At[4][2], B0[2][2], B1[2][2]; v8i32 At8[4], B08[2], B18[2];
    if constexpr (GATHER) PG8_GLOAD(0);
    const char* cA = (const char*)g.A + (GATHER ? (size_t)0 : (size_t)cur.pm * tstep); const char* cB = (const char*)g.Bt + (size_t)S.b_tile(cur) * tstep;
    PG8_STAGE(PG8_SB(0, 0), cB, voffB); PG8_STAGE(PG8_SB(0, 1), cB + hstep, voffB); PG8_STAGE(PG8_SA(0, 0), cA, vA0); PG8_STAGE(PG8_SA(0, 1), cA + hstepA, vA1);
    if (wr == 1) PG8_BAR;
    PG8_WAIT_V(2); PG8_BAR;
    PG8_STAGE(PG8_SB(1, 0), cB + kstep, voffB); PG8_STAGE(PG8_SA(1, 0), cA + kstep, vA0); PG8_STAGE(PG8_SB(1, 1), cB + hstep + kstep, voffB);
    PG8_WAIT_V(6); PG8_BAR;
    for (;;) {
        const bool has_next = S.next(ui + 1, nxt);
        const char* nA = has_next ? (const char*)g.A + (GATHER ? (size_t)0 : (size_t)nxt.pm * tstep) : cA; const char* nB = has_next ? (const char*)g.Bt + (size_t)S.b_tile(nxt) * tstep : cB;
#pragma unroll 1
        for (int t = 0; t < nt; t += 2) {
            const bool last = (t == nt - 2);
            const char* a1 = cA + (size_t)(t + 1) * kstep;
            const char* a2 = last ? nA : cA + (size_t)(t + 2) * kstep; const char* b2 = last ? nB : cB + (size_t)(t + 2) * kstep;
            const char* a3 = a2 + kstep; const char* b3 = b2 + kstep;
            PG8_LDB(B0, 0, 0); PG8_LDB(B1, 0, 1); PG8_SCHED; PG8_LDA(At, 0, 0); PG8_STAGE(PG8_SA(1, 1), a1 + hstepA, vA1);
            PG8_WAIT_V(8); PG8_WAIT_L(0); PG8_BAR; PG8_MMA(0, 0, At, B0); PG8_MMA(0, 1, At, B1); PG8_BAR; PG8_SCHED;
            if constexpr (GATHER) { if (last && has_next) { PG8_GLOAD(ui + 1); } }
            PG8_LDA(At, 0, 1); PG8_STAGE(PG8_SB(0, 0), b2, voffB); PG8_STAGE(PG8_SB(0, 1), b2 + hstep, voffB); PG8_STAGE(PG8_SA(0, 0), a2, vA0);
            PG8_WAIT_V(8); PG8_WAIT_L(0); PG8_BAR; PG8_MMA(1, 0, At, B0); PG8_MMA(1, 1, At, B1); PG8_BAR; PG8_SCHED;
            PG8_LDB(B0, 1, 0); PG8_LDB(B1, 1, 1); PG8_SCHED; PG8_LDA(At, 1, 0); PG8_STAGE(PG8_SA(0, 1), a2 + hstepA, vA1);
            PG8_WAIT_V(8); PG8_WAIT_L(0); PG8_BAR; PG8_MMA(0, 0, At, B0); PG8_MMA(0, 1, At, B1); PG8_BAR; PG8_SCHED;
            PG8_LDA(At, 1, 1); PG8_STAGE(PG8_SB(1, 0), b3, voffB); PG8_STAGE(PG8_SB(1, 1), b3 + hstep, voffB); PG8_STAGE(PG8_SA(1, 0), a3, vA0);
            PG8_WAIT_V(8); PG8_WAIT_L(0); PG8_BAR; PG8_MMA(1, 0, At, B0); PG8_MMA(1, 1, At, B1); PG8_BAR; PG8_SCHED;
        }
        if (wr == 0) PG8_BAR;
        if constexpr (FP8) asm volatile("s_nop 15\n\ts_nop 15" ::: "memory");
        E(acc, cur, S, wr, wc, fr, fq);
        if (!has_next) break;
#pragma unroll
        for (int a = 0; a < 2; ++a)
#pragma unroll
            for (int b = 0; b < 2; ++b)
#pragma unroll
                for (int m = 0; m < 4; ++m)
#pragma unroll
                    for (int n = 0; n < 2; ++n) acc[a][b][m][n] = (f32x4){0.f, 0.f, 0.f, 0.f};
        cur = nxt; cA = nA; cB = nB; ++ui;
        if (wr == 1) PG8_BAR;
    }
    PG8_WAIT_V(0);
    PG8_BAR;
#undef PG8_SA
#undef PG8_SB
#undef PG8_STAGE
#undef PG8_LDA
#undef PG8_LD8
#undef PG8_LDB
#undef PG8_MMA
#undef PG8_WAIT_V
#undef PG8_WAIT_L
#undef PG8_BAR
#undef PG8_SCHED
#undef PG8_GLOAD
}

struct EpiUQKV {
    static constexpr bool PERM = true;
    bf16_t* base; size_t stride;
    __device__ __forceinline__ void operator()(const Acc& acc, const Unit& u, const Order&, int wr, int wc, int fr, int fq) const {
        bf16_t* O = base + (size_t)(u.pn >> 1) * stride;
        const int row0 = u.pm * BM + wr * 64 + fr, col0 = (u.pn & 1) * 256 + wc * 32 + 8 * fq;
#pragma unroll
        for (int ai = 0; ai < 2; ++ai)
#pragma unroll
            for (int m = 0; m < 4; ++m) { bf16_t* rowp = O + (size_t)(row0 + ai * HALF + m * 16) * 512 + col0;
#pragma unroll
                for (int bj = 0; bj < 2; ++bj) { const f32x4 v0 = acc[ai][bj][m][0], v1 = acc[ai][bj][m][1];
                    u32x4 w; w.x = cvt_pk_bf16(v0[0], v0[1]); w.y = cvt_pk_bf16(v0[2], v0[3]); w.z = cvt_pk_bf16(v1[0], v1[1]); w.w = cvt_pk_bf16(v1[2], v1[3]);
                    *(u32x4*)(rowp + bj * HALF) = w; } }
    }
};
struct EpiBf16 {
    static constexpr bool PERM = true;
    bf16_t* O; int ldc;
    __device__ __forceinline__ void operator()(const Acc& acc, const Unit& u, const Order&, int wr, int wc, int fr, int fq) const {
        const int row0 = u.pm * BM + wr * 64 + fr, col0 = u.pn * BM + wc * 32 + 8 * fq;
#pragma unroll
        for (int ai = 0; ai < 2; ++ai)
#pragma unroll
            for (int m = 0; m < 4; ++m) { bf16_t* rowp = O + (size_t)(row0 + ai * HALF + m * 16) * ldc + col0;
#pragma unroll
                for (int bj = 0; bj < 2; ++bj) { const f32x4 v0 = acc[ai][bj][m][0], v1 = acc[ai][bj][m][1];
                    u32x4 w; w.x = cvt_pk_bf16(v0[0], v0[1]); w.y = cvt_pk_bf16(v0[2], v0[3]); w.z = cvt_pk_bf16(v1[0], v1[1]); w.w = cvt_pk_bf16(v1[2], v1[3]);
                    *(u32x4*)(rowp + bj * HALF) = w; } }
    }
};
struct EpiResF32 {
    static constexpr bool PERM = false;
    const float* base; float* out;
    __device__ __forceinline__ void operator()(const Acc& acc, const Unit& u, const Order&, int wr, int wc, int fr, int fq) const {
        const int row0 = u.pm * BM + wr * 64 + fr, col0 = u.pn * BM + wc * 32 + 4 * fq;
#pragma unroll
        for (int ai = 0; ai < 2; ++ai)
#pragma unroll
            for (int m = 0; m < 4; ++m) { const size_t off = (size_t)(row0 + ai * HALF + m * 16) * D + col0;
#pragma unroll
                for (int bj = 0; bj < 2; ++bj)
#pragma unroll
                    for (int n = 0; n < 2; ++n) { const f32x4 b = *(const f32x4*)(base + off + bj * HALF + n * 16); *(f32x4*)(out + off + bj * HALF + n * 16) = b + acc[ai][bj][m][n]; } }
    }
};
struct EpiSwiGLU {
    static constexpr bool PERM = true;
    unsigned char* H; const float* bgu;
    __device__ __forceinline__ void operator()(const Acc& acc, const Unit& u, const Order& S, int wr, int wc, int fr, int fq) const {
        const int e = S.expert(u);
        const int row0 = u.pm * BM + wr * 64 + fr, j0 = u.pn * 128 + wc * 32 + 8 * fq;
        const float* bg = bgu + (size_t)e * 2048 + j0; const float* bu = bg + 1024;
        const f32x4 bg0 = *(const f32x4*)bg, bg1 = *(const f32x4*)(bg + 4), bu0 = *(const f32x4*)bu, bu1 = *(const f32x4*)(bu + 4);
#pragma unroll
        for (int ai = 0; ai < 2; ++ai)
#pragma unroll
            for (int m = 0; m < 4; ++m) {
                float hv[8];
#pragma unroll
                for (int n = 0; n < 2; ++n) { const f32x4 gq = acc[ai][0][m][n] * WSCALE_INV + (n ? bg1 : bg0), uq = acc[ai][1][m][n] * WSCALE_INV + (n ? bu1 : bu0);
#pragma unroll
                    for (int x = 0; x < 4; ++x) { const float gg = fminf(gq[x], 7.0f), uu = fminf(fmaxf(uq[x], -7.0f), 7.0f);
                        hv[n * 4 + x] = (uu + 1.0f) * gg * __builtin_amdgcn_rcpf(1.0f + __builtin_amdgcn_exp2f(-1.702f * LOG2E * gg)); } }
                u32x2 w; w.x = pk_fp8x4(hv[0], hv[1], hv[2], hv[3]); w.y = pk_fp8x4(hv[4], hv[5], hv[6], hv[7]);
                *(u32x2*)(H + (size_t)(row0 + ai * HALF + m * 16) * 1024 + j0) = w; }
    }
};
struct EpiDown {
    static constexpr bool PERM = true;
    bf16_t* Y; const float* bdn;
    __device__ __forceinline__ void operator()(const Acc& acc, const Unit& u, const Order& S, int wr, int wc, int fr, int fq) const {
        const int e = S.expert(u);
        const int row0 = u.pm * BM + wr * 64 + fr, col0 = u.pn * BM + wc * 32 + 8 * fq;
        const float* bp = bdn + (size_t)e * 1024 + col0;
#pragma unroll
        for (int bj = 0; bj < 2; ++bj) { const f32x4 b0 = *(const f32x4*)(bp + bj * HALF), b1 = *(const f32x4*)(bp + bj * HALF + 4);
#pragma unroll
            for (int ai = 0; ai < 2; ++ai)
#pragma unroll
                for (int m = 0; m < 4; ++m) { const f32x4 v0 = acc[ai][bj][m][0] * WSCALE_INV + b0, v1 = acc[ai][bj][m][1] * WSCALE_INV + b1;
                    u32x4 w; w.x = cvt_pk_bf16(v0[0], v0[1]); w.y = cvt_pk_bf16(v0[2], v0[3]); w.z = cvt_pk_bf16(v1[0], v1[1]); w.w = cvt_pk_bf16(v1[2], v1[3]);
                    *(u32x4*)(Y + (size_t)(row0 + ai * HALF + m * 16) * 1024 + col0 + bj * HALF) = w; } }
    }
};
struct EpiPle {
    static constexpr bool PERM = false;
    const float* x2; const bf16_t* pp; float* out; float* rowss;
    __device__ __forceinline__ void operator()(const Acc& acc, const Unit& u, const Order&, int wr, int wc, int fr, int fq) const {
        const int row0 = u.pm * BM + wr * 64 + fr, col0 = u.pn * BM + wc * 32 + 4 * fq;
#pragma unroll
        for (int ai = 0; ai < 2; ++ai)
#pragma unroll
            for (int m = 0; m < 4; ++m) { const int row = row0 + ai * HALF + m * 16; const size_t off = (size_t)row * D + col0; float ss = 0.f;
#pragma unroll
                for (int bj = 0; bj < 2; ++bj)
#pragma unroll
                    for (int n = 0; n < 2; ++n) { const size_t o2 = off + bj * HALF + n * 16; const f32x4 xb = *(const f32x4*)(x2 + o2); const u32x2 pw = *(const u32x2*)(pp + o2);
                        const f32x4 a = acc[ai][bj][m][n]; f32x4 r;
                        r[0] = xb[0] + bflo(pw.x) * sigmoidf_fast(a[0]); r[1] = xb[1] + bfhi(pw.x) * sigmoidf_fast(a[1]);
                        r[2] = xb[2] + bflo(pw.y) * sigmoidf_fast(a[2]); r[3] = xb[3] + bfhi(pw.y) * sigmoidf_fast(a[3]);
                        ss += (r[0] * r[0] + r[1] * r[1]) + (r[2] * r[2] + r[3] * r[3]);
                        *(f32x4*)(out + o2) = r; }
                ss += __shfl_xor(ss, 16); ss += __shfl_xor(ss, 32);
                if (fq == 0) atomicAdd(rowss + row, ss); }
    }
};
}
namespace mk {
constexpr size_t MiB = 1u << 20;
constexpr size_t WS_CTL = 0, CTL_ZERO_BYTES = 1 * MiB;
constexpr int CW_TMO = 0, CW_CNT = 16384, CW_BAR = 4096;
constexpr size_t WS_ROWSS = 512 * 1024;
constexpr size_t WS_BIAS = 1 * MiB;
constexpr size_t WS_WPT = 1 * MiB + 64 * 1024;
constexpr size_t WS_WT_PP = 2 * MiB;
constexpr size_t WS_WT_IN = 4 * MiB;
constexpr size_t WS_WT_OUT = 8 * MiB;
constexpr size_t WS_WT_PG = 10 * MiB;
constexpr size_t WS_LIST = 12 * MiB;
constexpr size_t WS_TOKINFO = 14 * MiB;
constexpr size_t WS_LSE = 15 * MiB;
constexpr size_t WS_PB = 17 * MiB;
constexpr size_t WS_WT_GU = 32 * MiB;
constexpr size_t WS_XN8 = 96 * MiB;
constexpr size_t WS_WT_DN = 160 * MiB;
constexpr size_t WS_XN = 224 * MiB;
constexpr size_t WS_UQKV = 256 * MiB;
constexpr size_t WS_OB = 320 * MiB;
constexpr size_t WS_MIX = 368 * MiB;
constexpr size_t WS_PPB = 400 * MiB;
constexpr size_t WS_X1 = 432 * MiB;
constexpr size_t WS_X2 = 496 * MiB;
constexpr size_t WS_H = 560 * MiB;
constexpr size_t WS_Y = 704 * MiB;
constexpr size_t WS_END = 848 * MiB;

constexpr int RING_BYTES = 131072;
constexpr int L_MISC = RING_BYTES;
constexpr int L_CNT = L_MISC + 256;
constexpr int L_BASE = L_CNT + 128;
constexpr int L_TILE_E = L_BASE + 256;
constexpr int L_GTAB = L_TILE_E + 1280;
constexpr int MAXU = 12;
constexpr int LDS_BYTES = 163840;
static_assert(L_GTAB + MAXU * 1024 <= LDS_BYTES, "LDS map");

typedef GAS unsigned gu32;
#define RLX_AGENT __ATOMIC_RELAXED, __HIP_MEMORY_SCOPE_AGENT
#define LDS_WAIT() asm volatile("s_waitcnt lgkmcnt(0)" ::: "memory")
#define VM_WAIT() asm volatile("s_waitcnt vmcnt(0)" ::: "memory")

#define XB_TMO      128
#define XB_XCNT(j)  (256  + 64 * (j))
#define XB_XSUB(j)  (1280 + 64 * (j))
#define XB_XGEN(j)  (2304 + 64 * (j))
#define XB_TOP      3328
#define XB_TOPGEN   3392
#define XCD_BAR_WORDS 3456
#define XB_SPIN_CAP (1u << 18)
__device__ __forceinline__ unsigned xb_ld(unsigned* p)              { return __hip_atomic_load(p, __ATOMIC_RELAXED, __HIP_MEMORY_SCOPE_AGENT); }
__device__ __forceinline__ unsigned xb_add(unsigned* p, unsigned v) { return __hip_atomic_fetch_add(p, v, __ATOMIC_RELAXED, __HIP_MEMORY_SCOPE_AGENT); }
__device__ __forceinline__ unsigned xb_xcc_id() { return (unsigned)__builtin_amdgcn_s_getreg((3 << 11) | 20) & 0xFu; }
#define XB_SPIN(cond, bar) do { unsigned _sp = 0; while (cond) { __builtin_amdgcn_s_sleep(1); \
    if ((++_sp & 255u) == 0u) { if (xb_ld(&(bar)[XB_TMO])) break; if (_sp > XB_SPIN_CAP) { atomicAdd(&(bar)[XB_TMO], 1u); break; } } } } while (0)
struct XcdBarrier { unsigned* bar; unsigned x; volatile LAS unsigned* st; };
__device__ __forceinline__ XcdBarrier xcd_barrier_post(unsigned* bar, volatile LAS unsigned* st) {
    XcdBarrier b; b.bar = bar; b.x = xb_xcc_id(); b.st = st;
    if (threadIdx.x == 0) (void)xb_add(&bar[XB_XCNT(b.x)], 1u);
    return b;
}
__device__ __forceinline__ void xcd_barrier_complete(unsigned* bar, unsigned x, unsigned& nloc, unsigned& nx) {
    const unsigned G = gridDim.x * gridDim.y * gridDim.z;
    unsigned sum, cnt, mine, sp = 0u;
    for (;;) {
        sum = 0u; cnt = 0u; mine = 0u;
#pragma unroll
        for (unsigned j = 0; j < 16; ++j) { const unsigned c = xb_ld(&bar[XB_XCNT(j)]); sum += c; cnt += (c > 0u) ? 1u : 0u; mine = (j == x) ? c : mine; }
        if (sum == G) break;
        __builtin_amdgcn_s_sleep(1);
        if ((++sp & 255u) == 0u) { if (xb_ld(&bar[XB_TMO])) break; if (sp > XB_SPIN_CAP) { atomicAdd(&bar[XB_TMO], 1u); break; } }
    }
    nloc = mine > 0u ? mine : 1u; nx = cnt > 0u ? cnt : 1u;
}
__device__ __forceinline__ void xcd_barrier(const XcdBarrier& b) {
    asm volatile("s_waitcnt vmcnt(0)" ::: "memory");
    __syncthreads();
    if (threadIdx.x == 0) {
        unsigned* bar = b.bar;
        __builtin_amdgcn_s_waitcnt(0);
        unsigned nloc = b.st[0], nx = b.st[1];
        if (nloc == 0u) { xcd_barrier_complete(bar, b.x, nloc, nx); b.st[0] = nloc; b.st[1] = nx; }
        const unsigned old = xb_add(&bar[XB_XSUB(b.x)], 1u);
        const unsigned gen = old / nloc;
        if (old + 1u == (gen + 1u) * nloc) {
            __builtin_amdgcn_fence(__ATOMIC_RELEASE, "agent");
            asm volatile("s_waitcnt vmcnt(0)" ::: "memory");
            const unsigned og = xb_add(&bar[XB_TOP], 1u);
            const unsigned tg = og / nx;
            if (og + 1u == (tg + 1u) * nx) xb_add(&bar[XB_TOPGEN], 1u);
            else XB_SPIN(xb_ld(&bar[XB_TOPGEN]) == tg, bar);
            __builtin_amdgcn_fence(__ATOMIC_ACQUIRE, "agent");
            xb_add(&bar[XB_XGEN(b.x)], 1u);
            asm volatile("s_waitcnt vmcnt(0)" ::: "memory");
        } else {
            XB_SPIN(xb_ld(&bar[XB_XGEN(b.x)]) == gen, bar);
            __builtin_amdgcn_fence(__ATOMIC_ACQUIRE, "agent");
            asm volatile("s_waitcnt vmcnt(0)" ::: "memory");
        }
    }
    __syncthreads();
}

struct Args { const float* in[19]; float* out; unsigned char* ws; int ph_lo, ph_hi; };
struct Frame {
    LAS unsigned char* lds;
    int tid, lane, wave, vcu, G;
    unsigned char* ws;
    float* out;
};
__device__ __forceinline__ unsigned f2bf(float f) { unsigned u = __builtin_bit_cast(unsigned, f); return (u + 0x7fffu + ((u >> 16) & 1u)) >> 16; }
__device__ __forceinline__ unsigned pk2(float lo, float hi) { return f2bf(lo) | (f2bf(hi) << 16); }

__device__ __forceinline__ void p0_transpose_item(const float* W, int K, int N, bf16_t* WT, int k0, int n0, int drow0, LAS float* scr, int lane, float scale = 1.0f) {
#pragma unroll 8
    for (int i = 0; i < 32; ++i) { const int kk = 2 * i + (lane >> 5); scr[kk * 33 + (lane & 31)] = W[(size_t)(k0 + kk) * N + n0 + (lane & 31)] * scale; }
    LDS_WAIT(); asm volatile("" ::: "memory");
    const int c = lane & 7;
#pragma unroll
    for (int j = 0; j < 4; ++j) { const int n = (lane >> 3) + 8 * j; const LAS float* s = scr + (8 * c) * 33 + n;
        u32x4 o; o.x = pk2(s[0 * 33], s[1 * 33]); o.y = pk2(s[2 * 33], s[3 * 33]); o.z = pk2(s[4 * 33], s[5 * 33]); o.w = pk2(s[6 * 33], s[7 * 33]);
        *(GAS u32x4*)(WT + (size_t)(drow0 + n) * K + k0 + 8 * c) = o; }
    LDS_WAIT(); asm volatile("" ::: "memory");
}
__device__ __forceinline__ int t5_bucket(int dist) {
    if (dist < 16) return dist;
    const float n = (float)dist;
    int large = 16 + (int)(logf(n / 16.0f) / logf(128.0f) * 16.0f);
    return large < 31 ? large : 31;
}
__device__ __forceinline__ void rms_row_to_bf16(const float* xrow, const float* g, bf16_t* orow, int lane) {
    const f32x4* xr = (const f32x4*)xrow + lane; const f32x4* gr = (const f32x4*)g + lane;
    f32x4 v[4]; float s = 0.f;
#pragma unroll
    for (int j = 0; j < 4; ++j) { v[j] = xr[64 * j]; s += (v[j].x * v[j].x + v[j].y * v[j].y) + (v[j].z * v[j].z + v[j].w * v[j].w); }
    const float rstd = 1.f / sqrtf(wave_sum(s) * (1.f / D) + EPS);
    unsigned long long* o8 = (unsigned long long*)orow + lane;
#pragma unroll
    for (int j = 0; j < 4; ++j) { const f32x4 gg = gr[64 * j];
        o8[64 * j] = (unsigned long long)pk2(v[j].x * rstd * gg.x, v[j].y * rstd * gg.y) | ((unsigned long long)pk2(v[j].z * rstd * gg.z, v[j].w * rstd * gg.w) << 32); }
}
struct TItem { const float* W; bf16_t* WT; int K, N, k0, n0, drow0; float scale; int q; };
__device__ __forceinline__ TItem p0_decode(Frame& F, const Args& A, int r) {
    constexpr int I_GU = 32 * 16 * 32, I_DN = 32 * 16 * 16, I_IN = 16 * 32, I_OUT = 16 * 16, I_PG = 16 * 16, I_PP = 4 * 16;
    TItem t; t.scale = 1.0f; t.q = 0;
    if (r < I_GU) { const int e = r / 512, q = r % 512, kb = q / 32, nb = q % 32, n0 = nb * 64, half = n0 >> 10, j = n0 & 1023, pn = j >> 7, jj = j & 127;
        t.W = A.in[11] + (size_t)e * 1024 * 2048; t.WT = (bf16_t*)(F.ws + WS_WT_GU + (size_t)e * 2048 * 1024); t.scale = WSCALE; t.K = 1024; t.N = 2048; t.k0 = kb * 64; t.n0 = n0; t.drow0 = pn * 256 + half * 128 + jj; t.q = 1; return t; } r -= I_GU;
    if (r < I_DN) { const int e = r / 256, q = r % 256, kb = q / 16, nb = q % 16;
        t.W = A.in[13] + (size_t)e * 1024 * 1024; t.WT = (bf16_t*)(F.ws + WS_WT_DN + (size_t)e * 1024 * 1024); t.scale = WSCALE; t.K = 1024; t.N = 1024; t.k0 = kb * 64; t.n0 = nb * 64; t.drow0 = nb * 64; t.q = 1; return t; } r -= I_DN;
    if (r < I_IN) { const int kb = r / 32, nb = r % 32; t.W = A.in[3]; t.WT = (bf16_t*)(F.ws + WS_WT_IN); t.K = 1024; t.N = 2048; t.k0 = kb * 64; t.n0 = nb * 64; t.drow0 = nb * 64; t.scale = (nb >= 8 && nb < 16) ? QSCALE : 1.0f; return t; } r -= I_IN;
    if (r < I_OUT) { const int kb = r / 16, nb = r % 16; t.W = A.in[7]; t.WT = (bf16_t*)(F.ws + WS_WT_OUT); t.K = 1024; t.N = 1024; t.k0 = kb * 64; t.n0 = nb * 64; t.drow0 = nb * 64; return t; } r -= I_OUT;
    if (r < I_PG) { const int kb = r / 16, nb = r % 16; t.W = A.in[16]; t.WT = (bf16_t*)(F.ws + WS_WT_PG); t.K = 1024; t.N = 1024; t.k0 = kb * 64; t.n0 = nb * 64; t.drow0 = nb * 64; return t; } r -= I_PG;
    if (r < I_PP) { const int kb = r / 16, nb = r % 16; t.W = A.in[17]; t.WT = (bf16_t*)(F.ws + WS_WT_PP); t.K = 256; t.N = 1024; t.k0 = kb * 64; t.n0 = nb * 64; t.drow0 = nb * 64; return t; } r -= I_PP;
    { const int g = r / 4, q = r % 4, kb = q / 2, nb = q % 2; t.W = A.in[4] + (size_t)g * 128 * 128; t.WT = (bf16_t*)(F.ws + WS_WPT) + (size_t)g * 128 * 128; t.K = 128; t.N = 128; t.k0 = kb * 64; t.n0 = nb * 64; t.drow0 = nb * 64; return t; }
}
__device__ __forceinline__ void p0_prologue(Frame& F, const Args& A) {
    const int gw = F.vcu * 8 + F.wave, NGW = F.G * 8, lane = F.lane;
    LAS float* scr = (LAS float*)(F.lds + (F.wave < 7 ? F.wave * 16640 : 145280));
    constexpr int NITEMS = 32 * 16 * 32 + 32 * 16 * 16 + 16 * 32 + 16 * 16 + 16 * 16 + 4 * 16 + 16;
    {
        const int l4 = lane >> 4, l15 = lane & 15, c8 = lane & 7, nl = lane >> 3;
        f32x4 r[16];
        int it = gw; bool have = it < NITEMS; TItem cur;
        if (have) { cur = p0_decode(F, A, it);
#pragma unroll
            for (int i = 0; i < 16; ++i) r[i] = *(const f32x4*)(cur.W + (size_t)(cur.k0 + 4 * i + l4) * cur.N + cur.n0 + 4 * l15); }
        while (have) {
            const int nit = it + NGW; const bool hn = nit < NITEMS; TItem nx = cur; if (hn) nx = p0_decode(F, A, nit);
#pragma unroll
            for (int i = 0; i < 16; ++i) { const int kk = 4 * i + l4; f32x4 v = r[i] * cur.scale;
                scr[kk * 65 + 4 * l15 + 0] = v[0]; scr[kk * 65 + 4 * l15 + 1] = v[1]; scr[kk * 65 + 4 * l15 + 2] = v[2]; scr[kk * 65 + 4 * l15 + 3] = v[3]; }
            if (hn) {
#pragma unroll
                for (int i = 0; i < 16; ++i) r[i] = *(const f32x4*)(nx.W + (size_t)(nx.k0 + 4 * i + l4) * nx.N + nx.n0 + 4 * l15); }
            LDS_WAIT(); asm volatile("" ::: "memory");
            if (cur.q) {
                const int c4 = lane & 3, n4 = lane >> 2; unsigned char* W8 = (unsigned char*)cur.WT;
#pragma unroll
                for (int j = 0; j < 4; ++j) { const int n = n4 + 16 * j; const LAS float* sp = scr + (16 * c4) * 65 + n;
                    u32x4 o; o.x = pk_fp8x4(sp[0 * 65], sp[1 * 65], sp[2 * 65], sp[3 * 65]); o.y = pk_fp8x4(sp[4 * 65], sp[5 * 65], sp[6 * 65], sp[7 * 65]);
                    o.z = pk_fp8x4(sp[8 * 65], sp[9 * 65], sp[10 * 65], sp[11 * 65]); o.w = pk_fp8x4(sp[12 * 65], sp[13 * 65], sp[14 * 65], sp[15 * 65]);
                    *(GAS u32x4*)(W8 + (size_t)(cur.drow0 + n) * cur.K + cur.k0 + 16 * c4) = o; }
            } else {
#pragma unroll
            for (int j = 0; j < 8; ++j) { const int n = nl + 8 * j; const LAS float* sp = scr + (8 * c8) * 65 + n;
                u32x4 o; o.x = pk2(sp[0 * 65], sp[1 * 65]); o.y = pk2(sp[2 * 65], sp[3 * 65]); o.z = pk2(sp[4 * 65], sp[5 * 65]); o.w = pk2(sp[6 * 65], sp[7 * 65]);
                *(GAS u32x4*)(cur.WT + (size_t)(cur.drow0 + n) * cur.K + cur.k0 + 8 * c8) = o; }
            }
            LDS_WAIT(); asm volatile("" ::: "memory");
            it = nit; cur = nx; have = hn;
        }
    }
    bf16_t* XN = (bf16_t*)(F.ws + WS_XN);
    for (int m = gw; m < T; m += NGW) rms_row_to_bf16(A.in[0] + (size_t)m * D, A.in[2], XN + (size_t)m * D, lane);
    bf16_t* PB = (bf16_t*)(F.ws + WS_PB);
    for (int m = gw; m < T; m += NGW) { const f32x4 v = ((const f32x4*)(A.in[1] + (size_t)m * PLE))[lane];
        ((unsigned long long*)(PB + (size_t)m * PLE))[lane] = (unsigned long long)pk2(v.x, v.y) | ((unsigned long long)pk2(v.z, v.w) << 32); }
    if (blockIdx.x == 0) { float* BT = (float*)(F.ws + WS_BIAS);
        for (int i = F.tid; i < 3 * 8 * 132; i += 512) { const int br = i / (8 * 132), h = (i / 132) % 8, rel = i % 132; const int dil = br == 0 ? 1 : (br == 1 ? 4 : 16);
            BT[i] = rel <= 128 ? A.in[6][t5_bucket(rel * dil) * 8 + h] * LOG2E : 0.f; } }
}

__device__ __forceinline__ int fK(int row) { return (row >> 1) & 7; }
__device__ __forceinline__ int fV(int row) { return ((row >> 1) & 1) << 2; }
__device__ __forceinline__ int crow(int r, int hi) { return (r & 3) + 8 * (r >> 2) + 4 * hi; }
__device__ __forceinline__ s16x4 tr_read(LAS const unsigned char* p) { typedef short v4i16_t __attribute__((ext_vector_type(4)));
    return __builtin_bit_cast(s16x4, __builtin_amdgcn_ds_read_tr16_b64_v4i16((LAS v4i16_t*)p)); }
__device__ __forceinline__ void attn_phase(Frame& F, const Args& A) {
    const int lane = F.lane, w = F.wave, r32 = lane & 31, hi = lane >> 5;
    const bf16_t* QB = (const bf16_t*)(F.ws + WS_UQKV) + (size_t)1 * T * 512; const bf16_t* KB = QB + (size_t)T * 512; const bf16_t* VB = KB + (size_t)T * 512;
    bf16_t* OB = (bf16_t*)(F.ws + WS_OB); float* LSE = (float*)(F.ws + WS_LSE); const float* BT = (const float*)(F.ws + WS_BIAS);
    LAS unsigned char* Kl = F.lds; LAS unsigned char* Vl = F.lds + 49152;
    constexpr int NITEM = 4 * 8 * 3 * 16;
    const int ipc = (NITEM + F.G - 1) / F.G;
    for (int it = F.vcu * ipc; it < NITEM && it < (F.vcu + 1) * ipc; ++it) {
        const int bh = it / 48, sub = it % 48, br = sub / 16, q16 = sub % 16;
        const int b = bh >> 3, h = bh & 7;
        const int dsh = br * 2, d = 1 << dsh;
        const int nblk = 16 >> dsh;
        const int r = q16 / nblk, m = q16 % nblk;
        const int lbase = 256 * m - 128;
        const size_t rowb = (size_t)b * S;
#pragma unroll
        for (int pi = 0; pi < 6; ++pi) { const int piece = w + 8 * pi, row = piece * 8 + (lane >> 3), cp = lane & 7;
            int lp = lbase + row; lp = lp < 0 ? 0 : lp;
            const size_t tok = rowb + (size_t)lp * d + r;
            const bf16_t* ks = KB + tok * 512 + h * 64 + ((cp ^ fK(row)) << 3);
            const bf16_t* vs = VB + tok * 512 + h * 64 + ((cp ^ fV(row)) << 3);
            __builtin_amdgcn_global_load_lds((const unsigned*)ks, (LAS unsigned*)(Kl + piece * 1024), 16, 0, 0);
            __builtin_amdgcn_global_load_lds((const unsigned*)vs, (LAS unsigned*)(Vl + piece * 1024), 16, 0, 0); }
        const int lq = 256 * m + 32 * w + r32;
        const size_t qtok = rowb + (size_t)lq * d + r;
        bf16x8 qf[4];
#pragma unroll
        for (int d0 = 0; d0 < 4; ++d0) qf[d0] = *(const bf16x8*)(QB + qtok * 512 + h * 64 + d0 * 16 + hi * 8);
        LAS float* btl = (LAS float*)(F.lds + 98304);
        if (F.tid < 132) btl[F.tid] = BT[(br * 8 + h) * 132 + F.tid];
        VM_WAIT(); LDS_WAIT(); __syncthreads();
        f32x16 p[5];
        int r32v = r32, hiv = hi; asm volatile("" : "+v"(r32v), "+v"(hiv));
        float mx = -3.0e38f;
#pragma unroll
        for (int jt = 0; jt < 5; ++jt) {
            const int krow = 32 * w + 32 * jt + r32;
            f32x16 acc = {};
#pragma unroll
            for (int d0 = 0; d0 < 4; ++d0) { const bf16x8 kf = *(const LAS bf16x8*)(Kl + krow * 128 + (((2 * d0 + hi) ^ fK(krow)) << 4));
                acc = __builtin_amdgcn_mfma_f32_32x32x16_bf16(kf, qf[d0], acc, 0, 0, 0); }
#pragma unroll
            for (int rr = 0; rr < 16; ++rr) { const int kk = crow(rr, hiv); const int rel = 128 + r32v - 32 * jt - kk; const int lp = lbase + 32 * w + 32 * jt + kk;
                const bool ok = (rel >= 0) && (rel <= 128) && (lp >= 0);
                const float sv = ok ? acc[rr] + btl[ok ? rel : 0] : -3.0e38f;
                acc[rr] = sv; mx = fmaxf(mx, sv); }
            p[jt] = acc;
            __builtin_amdgcn_sched_barrier(0);
        }
        { const float o = __shfl_xor(mx, 32); mx = fmaxf(mx, o); }
        float ls = 0.f;
#pragma unroll
        for (int jt = 0; jt < 5; ++jt)
#pragma unroll
            for (int rr = 0; rr < 16; ++rr) { const float e = __builtin_amdgcn_exp2f(p[jt][rr] - mx); p[jt][rr] = e; ls += e; }
        ls += __shfl_xor(ls, 32);
        __builtin_amdgcn_sched_barrier(0);
        f32x16 o[2]; o[0] = (f32x16){}; o[1] = (f32x16){};
#pragma unroll
        for (int jt = 0; jt < 5; ++jt)
#pragma unroll
            for (int s = 0; s < 2; ++s) {
                u32x4 pw; pw.x = cvt_pk_bf16(p[jt][8 * s + 0], p[jt][8 * s + 1]); pw.y = cvt_pk_bf16(p[jt][8 * s + 2], p[jt][8 * s + 3]);
                pw.z = cvt_pk_bf16(p[jt][8 * s + 4], p[jt][8 * s + 5]); pw.w = cvt_pk_bf16(p[jt][8 * s + 6], p[jt][8 * s + 7]);
                const bf16x8 pf = __builtin_bit_cast(bf16x8, pw);
                const int g = lane >> 4, qq = (lane & 15) >> 2, pp = lane & 3;
                const int key0 = 32 * w + 32 * jt + 16 * s + 4 * (g >> 1);
#pragma unroll
                for (int d0 = 0; d0 < 2; ++d0) {
                    const int dcol = 32 * d0 + 16 * (g & 1) + 4 * pp;
                    const int ra = key0 + qq, rb = key0 + 8 + qq;
                    const s16x4 lo = tr_read(Vl + ra * 128 + (((dcol >> 3) ^ fV(ra)) << 4) + (dcol & 7) * 2);
                    const s16x4 hh = tr_read(Vl + rb * 128 + (((dcol >> 3) ^ fV(rb)) << 4) + (dcol & 7) * 2);
                    const bf16x8 vf = (bf16x8){lo[0], lo[1], lo[2], lo[3], hh[0], hh[1], hh[2], hh[3]};
                    o[d0] = __builtin_amdgcn_mfma_f32_32x32x16_bf16(vf, pf, o[d0], 0, 0, 0);
                }
                __builtin_amdgcn_sched_barrier(0);
            }
        const float inv = 1.0f / ls;
        bf16_t* op = OB + ((size_t)br * T + qtok) * 512 + h * 64;
#pragma unroll
        for (int d0 = 0; d0 < 2; ++d0)
#pragma unroll
            for (int g4 = 0; g4 < 4; ++g4) { u32x2 wv; wv.x = cvt_pk_bf16(o[d0][4 * g4 + 0] * inv, o[d0][4 * g4 + 1] * inv); wv.y = cvt_pk_bf16(o[d0][4 * g4 + 2] * inv, o[d0][4 * g4 + 3] * inv);
                *(u32x2*)(op + 32 * d0 + 8 * g4 + 4 * hi) = wv; }
        if (hi == 0) LSE[((size_t)br * T + qtok) * 8 + h] = mx + __builtin_amdgcn_logf(ls);
        LDS_WAIT(); __syncthreads();
    }
}

__device__ __forceinline__ void merge_pool_phase(Frame& F, const Args& A) {
    const int gw = F.vcu * 8 + F.wave, NGW = F.G * 8, lane = F.lane;
    const bf16_t* OB = (const bf16_t*)(F.ws + WS_OB); const float* LSE = (const float*)(F.ws + WS_LSE); bf16_t* MIX = (bf16_t*)(F.ws + WS_MIX);
    for (int t = gw; t < T; t += NGW) {
        const int h = lane >> 3;
        const float l0 = LSE[((size_t)0 * T + t) * 8 + h], l1 = LSE[((size_t)1 * T + t) * 8 + h], l2 = LSE[((size_t)2 * T + t) * 8 + h];
        const float mm = fmaxf(l0, fmaxf(l1, l2));
        float w0 = __builtin_amdgcn_exp2f(l0 - mm), w1 = __builtin_amdgcn_exp2f(l1 - mm), w2 = __builtin_amdgcn_exp2f(l2 - mm);
        const float inv = 1.0f / (w0 + w1 + w2); w0 *= inv; w1 *= inv; w2 *= inv;
        const u32x4 a = *(const u32x4*)(OB + ((size_t)0 * T + t) * 512 + lane * 8), bq = *(const u32x4*)(OB + ((size_t)1 * T + t) * 512 + lane * 8), c = *(const u32x4*)(OB + ((size_t)2 * T + t) * 512 + lane * 8);
        u32x4 o;
#pragma unroll
        for (int i = 0; i < 4; ++i) { const float lo = w0 * bflo(a[i]) + w1 * bflo(bq[i]) + w2 * bflo(c[i]), hi = w0 * bfhi(a[i]) + w1 * bfhi(bq[i]) + w2 * bfhi(c[i]); o[i] = cvt_pk_bf16(lo, hi); }
        *(u32x4*)(MIX + (size_t)t * 1024 + 512 + lane * 8) = o;
    }
    const bf16_t* UB = (const bf16_t*)(F.ws + WS_UQKV); const bf16_t* WPT = (const bf16_t*)(F.ws + WS_WPT); const float* pscale = A.in[5];
    const int r32 = lane & 31, hi = lane >> 5;
    for (int it = gw; it < (T / 32) * 4; it += NGW) {
        const int g = it & 3, t0 = (it >> 2) * 32, tok = t0 + r32, tin = tok & (S - 1), wdw = 2 << g;
        const int cnt = (tin + 1 < wdw) ? tin + 1 : wdw; const float rc = 1.0f / (float)cnt;
        bf16x8 bfrag[8];
#pragma unroll
        for (int s = 0; s < 8; ++s) {
            const bf16_t* up = UB + (size_t)tok * 512 + g * 128 + 16 * s + 8 * hi;
            float sum[8]; const u32x4 cur = *(const u32x4*)up;
#pragma unroll
            for (int i = 0; i < 4; ++i) { sum[2 * i] = bflo(cur[i]); sum[2 * i + 1] = bfhi(cur[i]); }
            for (int j = 1; j < cnt; ++j) { const u32x4 v = *(const u32x4*)(up - (size_t)j * 512);
#pragma unroll
                for (int i = 0; i < 4; ++i) { sum[2 * i] += bflo(v[i]); sum[2 * i + 1] += bfhi(v[i]); } }
            u32x4 pw;
#pragma unroll
            for (int i = 0; i < 4; ++i) pw[i] = cvt_pk_bf16(sum[2 * i] * rc - bflo(cur[i]), sum[2 * i + 1] * rc - bfhi(cur[i]));
            bfrag[s] = __builtin_bit_cast(bf16x8, pw);
        }
#pragma unroll
        for (int db = 0; db < 4; ++db) {
            f32x16 acc = {};
#pragma unroll
            for (int s = 0; s < 8; ++s) { const bf16x8 af = *(const bf16x8*)(WPT + ((size_t)g * 128 + 32 * db + r32) * 128 + 16 * s + 8 * hi);
                acc = __builtin_amdgcn_mfma_f32_32x32x16_bf16(af, bfrag[s], acc, 0, 0, 0); }
#pragma unroll
            for (int g4 = 0; g4 < 4; ++g4) { const int dd = g * 128 + 32 * db + 8 * g4 + 4 * hi; const f32x4 sc = *(const f32x4*)(pscale + dd);
                u32x2 wv; wv.x = cvt_pk_bf16(acc[4 * g4 + 0] * sc[0], acc[4 * g4 + 1] * sc[1]); wv.y = cvt_pk_bf16(acc[4 * g4 + 2] * sc[2], acc[4 * g4 + 3] * sc[3]);
                *(u32x2*)(MIX + (size_t)tok * 1024 + dd) = wv; }
        }
    }
}
}
namespace mk {
constexpr int CNT_STRIDE = 64;
__device__ __forceinline__ void router_phase(Frame& F, const Args& A, bool dummy = false) {
    const int lane = F.lane, gw = F.vcu * 8 + F.wave, NGW = F.G * 8;
    const float* X1 = (const float*)(F.ws + WS_X1); const float* g_ffn = A.in[8]; const float* w_r = A.in[9]; const float* b_r = A.in[10];
    unsigned char* XN8 = (unsigned char*)(F.ws + WS_XN8); int* LIST = (int*)(F.ws + WS_LIST); u32x2* TOKINFO = (u32x2*)(F.ws + WS_TOKINFO);
    unsigned* cntg = (unsigned*)(F.ws + WS_CTL) + CW_CNT;
    if (dummy) { cntg += 32 * CNT_STRIDE; LIST = (int*)(F.ws + WS_H); TOKINFO = (u32x2*)(F.ws + WS_H + 4 * MiB); }
    LAS f32x4* wl = (LAS f32x4*)F.lds;
    LAS int* lcnt = (LAS int*)(F.lds + L_GTAB);
    LAS int* sel_t = lcnt + 64;
    LAS unsigned* sel_e = (LAS unsigned*)(lcnt + 192);
    LAS float* sel_g = (LAS float*)(lcnt + 704);
    for (int i = F.tid; i < 1024 * 8; i += 512) { const int k = i >> 3, c = i & 7; f32x4 v = *(const f32x4*)(w_r + (size_t)k * 32 + c * 4); v = v * g_ffn[k]; wl[k * 8 + (c ^ ((k >> 1) & 7))] = v; }
    if (F.tid < 32) lcnt[F.tid] = 0;
    LDS_WAIT(); __syncthreads();
    const float bias_e = b_r[(lane >> 1) & 31];
    int li = F.wave * 16;
    for (int t0 = gw * 2; t0 < T; t0 += NGW * 2) {
        float xa[16], xb[16]; float sa = 0.f, sb = 0.f;
#pragma unroll
        for (int i = 0; i < 16; ++i) { xa[i] = X1[(size_t)t0 * D + lane + 64 * i]; xb[i] = X1[(size_t)(t0 + 1) * D + lane + 64 * i]; sa += xa[i] * xa[i]; sb += xb[i] * xb[i]; }
        const float ra = 1.f / sqrtf(wave_sum(sa) * (1.f / D) + EPS), rb = 1.f / sqrtf(wave_sum(sb) * (1.f / D) + EPS);
        float aa[32], ab[32];
#pragma unroll
        for (int e = 0; e < 32; ++e) { aa[e] = 0.f; ab[e] = 0.f; }
#pragma unroll
        for (int i = 0; i < 16; ++i) { const int k = lane + 64 * i; const float va = xa[i], vb = xb[i];
#pragma unroll
            for (int c = 0; c < 8; ++c) { const f32x4 wv = wl[k * 8 + (c ^ ((k >> 1) & 7))];
#pragma unroll
                for (int x = 0; x < 4; ++x) { aa[4 * c + x] = fmaf(va, wv[x], aa[4 * c + x]); ab[4 * c + x] = fmaf(vb, wv[x], ab[4 * c + x]); } }
            asm volatile("" ::: "memory"); }
#pragma unroll
        for (int i = 0; i < 16; ++i) { const int k = lane + 64 * i; const float gk = g_ffn[k];
            const unsigned pa = (unsigned)__builtin_amdgcn_cvt_pk_fp8_f32(xa[i] * ra * gk, xb[i] * rb * gk, 0, false);
            XN8[(size_t)t0 * D + k] = (unsigned char)(pa & 0xffu); XN8[(size_t)(t0 + 1) * D + k] = (unsigned char)((pa >> 8) & 0xffu); }
#define RSTEP(N, MASK) \
        _Pragma("unroll") for (int i = 0; i < N; ++i) { const bool up = (lane & MASK) != 0; \
            { const float keep = up ? aa[i + N] : aa[i], send = up ? aa[i] : aa[i + N]; aa[i] = keep + __shfl_xor(send, MASK); } \
            { const float keep = up ? ab[i + N] : ab[i], send = up ? ab[i] : ab[i + N]; ab[i] = keep + __shfl_xor(send, MASK); } }
        RSTEP(16, 32) RSTEP(8, 16) RSTEP(4, 8) RSTEP(2, 4) RSTEP(1, 2)
#undef RSTEP
        float la = aa[0] + __shfl_xor(aa[0], 1), lb = ab[0] + __shfl_xor(ab[0], 1);
        la = la * ra + bias_e; lb = lb * rb + bias_e;
        const int my_e = (lane >> 1) & 31;
#pragma unroll
        for (int row = 0; row < 2; ++row) {
            float v = row ? lb : la; const int t = t0 + row;
            float tv[4]; int ti[4];
#pragma unroll
            for (int k = 0; k < 4; ++k) {
                float bv = v; int bi = my_e;
#pragma unroll
                for (int o = 2; o < 64; o <<= 1) { const float ov = __shfl_xor(bv, o); const int oi = __shfl_xor(bi, o); if (ov > bv || (ov == bv && oi < bi)) { bv = ov; bi = oi; } }
                tv[k] = bv; ti[k] = bi; if (my_e == bi) v = -INFINITY;
            }
            const float e1 = __expf(tv[1] - tv[0]), e2 = __expf(tv[2] - tv[0]), e3 = __expf(tv[3] - tv[0]); const float inv = 1.0f / (1.0f + e1 + e2 + e3);
            if (lane < 4) { const int e = lane == 0 ? ti[0] : (lane == 1 ? ti[1] : (lane == 2 ? ti[2] : ti[3])); const float gt = (lane == 0 ? 1.0f : (lane == 1 ? e1 : (lane == 2 ? e2 : e3))) * inv;
                const int rank = __hip_atomic_fetch_add(lcnt + e, 1, __ATOMIC_RELAXED, __HIP_MEMORY_SCOPE_WORKGROUP);
                sel_e[li * 4 + lane] = (unsigned)e | ((unsigned)rank << 8); sel_g[li * 4 + lane] = gt; if (lane == 0) sel_t[li] = t; }
            ++li;
        }
    }
    const int nloc = li - F.wave * 16;
    LDS_WAIT(); __syncthreads();
    if (F.tid < 32) { const int c = lcnt[F.tid]; const unsigned base = c ? __hip_atomic_fetch_add(cntg + F.tid * CNT_STRIDE, (unsigned)c, RLX_AGENT) : 0u; lcnt[F.tid] = (int)base; }
    LDS_WAIT(); __syncthreads();
    { const int w = F.tid >> 6, r = (F.tid & 63) >> 2, k = F.tid & 3;
      if (r < nloc) { const int l2 = w * 16 + r; const unsigned ev = sel_e[l2 * 4 + k]; const int e = (int)(ev & 0xffu); const unsigned pos = (unsigned)lcnt[e] + (ev >> 8); const int t = sel_t[l2];
          LIST[(size_t)e * T + pos] = t; u32x2 ti2; ti2.x = ((unsigned)e << 16) | pos; ti2.y = __float_as_uint(sel_g[l2 * 4 + k]); TOKINFO[(size_t)t * 4 + k] = ti2; } }
    LDS_WAIT(); __syncthreads();
}

__device__ __forceinline__ int moe_setup(Frame& F) {
    LAS int* Lcnt = (LAS int*)(F.lds + L_CNT); LAS int* Lbase = (LAS int*)(F.lds + L_BASE); LAS int* Ltile = (LAS int*)(F.lds + L_TILE_E);
    const unsigned* cntg = (const unsigned*)(F.ws + WS_CTL) + CW_CNT;
    if (F.tid < 64) {
        const int e = F.lane & 31; const int c = (int)__hip_atomic_load(cntg + e * CNT_STRIDE, RLX_AGENT); const int tl = (c + 255) >> 8;
        int incl = tl;
#pragma unroll
        for (int o = 1; o < 32; o <<= 1) { const int v = __shfl_up(incl, o); if ((F.lane & 31) >= o) incl += v; }
        const int excl = incl - tl;
        if (F.lane < 32) { Lcnt[e] = c; Lbase[e] = excl; if (e == 31) Lbase[32] = incl; for (int i = 0; i < tl; ++i) Ltile[excl + i] = e; }
    }
    LDS_WAIT(); __syncthreads();
    return __builtin_amdgcn_readfirstlane(Lbase[32]);
}
__device__ __forceinline__ void moe_gather_table(Frame& F, const Order& S) {
    LAS int* Lcnt = (LAS int*)(F.lds + L_CNT); LAS int* Lbase = (LAS int*)(F.lds + L_BASE); LAS int* Ltile = (LAS int*)(F.lds + L_TILE_E); LAS int* gt = (LAS int*)(F.lds + L_GTAB);
    const int* LIST = (const int*)(F.ws + WS_LIST);
    Unit u;
    for (int i = 0; i < MAXU && S.next(i, u); ++i) {
        if (F.tid < 256) { const int e = Ltile[u.pm]; const int idx = (u.pm - Lbase[e]) * 256 + F.tid; const int tok = idx < Lcnt[e] ? LIST[(size_t)e * T + idx] : 0; gt[i * 256 + F.tid] = tok * 1024; }
    }
    LDS_WAIT(); __syncthreads();
}

__device__ __forceinline__ void combine_phase(Frame& F, const Args& A) {
    const int lane = F.lane, gw = F.vcu * 8 + F.wave, NGW = F.G * 8;
    const float* X1 = (const float*)(F.ws + WS_X1); float* X2 = (float*)(F.ws + WS_X2); const bf16_t* Y = (const bf16_t*)(F.ws + WS_Y); bf16_t* XN = (bf16_t*)(F.ws + WS_XN);
    const u32x2* TOKINFO = (const u32x2*)(F.ws + WS_TOKINFO); const float* g_ple = A.in[15];
    LAS int* Lbase = (LAS int*)(F.lds + L_BASE);
    for (int t = gw; t < T; t += NGW) {
        f32x4 v[4];
#pragma unroll
        for (int j = 0; j < 4; ++j) v[j] = ((const f32x4*)(X1 + (size_t)t * D))[lane + 64 * j];
#pragma unroll
        for (int k = 0; k < 4; ++k) { const u32x2 ti = TOKINFO[(size_t)t * 4 + k]; const int e = (int)(ti.x >> 16), pos = (int)(ti.x & 0xffffu); const float gt = __uint_as_float(ti.y);
            const size_t row = (size_t)Lbase[e] * 256 + pos; const u32x2* yr = (const u32x2*)(Y + row * 1024);
#pragma unroll
            for (int j = 0; j < 4; ++j) { const u32x2 yv = yr[lane + 64 * j]; v[j].x += gt * bflo(yv.x); v[j].y += gt * bfhi(yv.x); v[j].z += gt * bflo(yv.y); v[j].w += gt * bfhi(yv.y); } }
        float s = 0.f;
#pragma unroll
        for (int j = 0; j < 4; ++j) { ((f32x4*)(X2 + (size_t)t * D))[lane + 64 * j] = v[j]; s += (v[j].x * v[j].x + v[j].y * v[j].y) + (v[j].z * v[j].z + v[j].w * v[j].w); }
        const float rstd = 1.f / sqrtf(wave_sum(s) * (1.f / D) + EPS);
        unsigned long long* o8 = (unsigned long long*)(XN + (size_t)t * D) + lane;
#pragma unroll
        for (int j = 0; j < 4; ++j) { const f32x4 gg = ((const f32x4*)g_ple)[lane + 64 * j];
            o8[64 * j] = (unsigned long long)pk2(v[j].x * rstd * gg.x, v[j].y * rstd * gg.y) | ((unsigned long long)pk2(v[j].z * rstd * gg.z, v[j].w * rstd * gg.w) << 32); }
    }
}
__device__ __forceinline__ void final_phase(Frame& F, const Args& A) {
    const int lane = F.lane, gw = F.vcu * 8 + F.wave, NGW = F.G * 8;
    const float* rowss = (const float*)(F.ws + WS_ROWSS); const float* g_final = A.in[18];
    for (int t = gw; t < T; t += NGW) {
        const float rstd = 1.f / sqrtf(rowss[t] * (1.f / D) + EPS);
#pragma unroll
        for (int j = 0; j < 4; ++j) { f32x4* p = (f32x4*)(F.out + (size_t)t * D) + lane + 64 * j; const f32x4 gg = ((const f32x4*)g_final)[lane + 64 * j]; f32x4 v = *p; v = v * rstd * gg; *p = v; }
    }
}

#ifndef DUP
#define DUP (-1)
#endif
__global__ void __launch_bounds__(512, 2) mega_fwd(Args args) {
    extern __shared__ __attribute__((aligned(16))) unsigned char lds_raw[];
    Frame F;
    F.lds = (LAS unsigned char*)lds_raw;
    F.tid = threadIdx.x; F.lane = F.tid & 63; F.wave = __builtin_amdgcn_readfirstlane(F.tid >> 6);
    F.G = gridDim.x; { const int bx = blockIdx.x; F.vcu = (F.G % 8 == 0) ? (bx % 8) * (F.G / 8) + bx / 8 : bx; }
    F.ws = args.ws; F.out = args.out;
    volatile LAS unsigned* MISC = (volatile LAS unsigned*)(F.lds + L_MISC);
    if (F.tid < 64) MISC[F.tid] = 0u;
    __syncthreads();
    unsigned* ctl = (unsigned*)(F.ws + WS_CTL);
    XcdBarrier bar = xcd_barrier_post(ctl + CW_BAR, MISC + 8);
    const int lo = args.ph_lo, hi = args.ph_hi;
#define IN(k) (lo <= (k) && (k) < hi)
#define SEAM(k) do { if (IN(k) && IN((k) + 1)) { xcd_barrier(bar); if (DUP == 20) xcd_barrier(bar); } } while (0)
    LAS unsigned char* ring = F.lds;
#ifndef ONLYP
#define ONLYP (-1)
#endif
#define RUN(k, BODY) do { if constexpr (ONLYP < 0 || ONLYP == (k)) { if (IN(k)) { BODY if (DUP == (k)) { BODY } } } } while (0)
#define P1_BODY \
        { Gemm g{(const bf16_t*)(F.ws + WS_XN), (const bf16_t*)(F.ws + WS_WT_IN), 1024}; Order S; S.init(T / 256, 2048 / 256, F.G, (int)blockIdx.x, nullptr); \
          EpiUQKV E{(bf16_t*)(F.ws + WS_UQKV), (size_t)T * 512}; gemm_phase<EpiUQKV, false>(ring, g, S, E, nullptr); } \
        { Gemm g{(const bf16_t*)(F.ws + WS_PB), (const bf16_t*)(F.ws + WS_WT_PP), 256}; Order S; S.init(T / 256, 1024 / 256, F.G, (int)blockIdx.x, nullptr); \
          EpiBf16 E{(bf16_t*)(F.ws + WS_PPB), 1024}; gemm_phase<EpiBf16, false>(ring, g, S, E, nullptr); }
#define P4_BODY \
        { Gemm g{(const bf16_t*)(F.ws + WS_MIX), (const bf16_t*)(F.ws + WS_WT_OUT), 1024}; Order S; S.init(T / 256, 1024 / 256, F.G, (int)blockIdx.x, nullptr); \
          EpiResF32 E{args.in[0], (float*)(F.ws + WS_X1)}; gemm_phase<EpiResF32, false>(ring, g, S, E, nullptr); }
#define P6_BODY \
        { Gemm g{(const bf16_t*)(F.ws + WS_XN8), (const bf16_t*)(F.ws + WS_WT_GU), 512}; Order S; S.init(ntiles, 8, F.G, (int)blockIdx.x, Ltile); \
          moe_gather_table(F, S); \
          EpiSwiGLU E{(unsigned char*)(F.ws + WS_H), args.in[12]}; gemm_phase<EpiSwiGLU, true, true>(ring, g, S, E, (const LAS int*)(F.lds + L_GTAB)); }
#define P7_BODY \
        { Gemm g{(const bf16_t*)(F.ws + WS_H), (const bf16_t*)(F.ws + WS_WT_DN), 512}; Order S; S.init(ntiles, 4, F.G, (int)blockIdx.x, Ltile); \
          EpiDown E{(bf16_t*)(F.ws + WS_Y), args.in[14]}; gemm_phase<EpiDown, false, true>(ring, g, S, E, nullptr); }
#define P9_BODY \
        { Gemm g{(const bf16_t*)(F.ws + WS_XN), (const bf16_t*)(F.ws + WS_WT_PG), 1024}; Order S; S.init(T / 256, 1024 / 256, F.G, (int)blockIdx.x, nullptr); \
          EpiPle E{(const float*)(F.ws + WS_X2), (const bf16_t*)(F.ws + WS_PPB), F.out, (float*)(F.ws + WS_ROWSS)}; gemm_phase<EpiPle, false>(ring, g, S, E, nullptr); }
    RUN(0, p0_prologue(F, args););
    SEAM(0);
    RUN(1, P1_BODY);
    SEAM(1);
    RUN(2, attn_phase(F, args););
    SEAM(2);
    RUN(3, merge_pool_phase(F, args););
    SEAM(3);
    RUN(4, P4_BODY);
    SEAM(4);
    if (IN(5)) { router_phase(F, args); if (DUP == 5) router_phase(F, args, true); }
    SEAM(5);
    if (IN(6) || IN(7) || IN(8)) {
        const int ntiles = moe_setup(F);
        const LAS int* Ltile = (const LAS int*)(F.lds + L_TILE_E);
        RUN(6, P6_BODY);
        SEAM(6);
        RUN(7, P7_BODY);
        SEAM(7);
        RUN(8, combine_phase(F, args););
    }
    SEAM(8);
    if (IN(9)) { P9_BODY if (DUP == 9) { Gemm g{(const bf16_t*)(F.ws + WS_XN), (const bf16_t*)(F.ws + WS_WT_PG), 1024}; Order S; S.init(T / 256, 1024 / 256, F.G, (int)blockIdx.x, nullptr); EpiPle E{(const float*)(F.ws + WS_X2), (const bf16_t*)(F.ws + WS_PPB), F.out, (float*)(F.ws + WS_H)}; gemm_phase<EpiPle, false>(ring, g, S, E, nullptr); } }
    SEAM(9);
    if (IN(10)) final_phase(F, args);
#undef RUN
#undef IN
#undef SEAM
}

static int g_grid = 0;
static bool launch_phases(void* const* d_in, void* d_out, void* d_ws, size_t ws_size, hipStream_t stream, int lo, int hi) {
    if (g_grid == 0) {
        int dev = 0, cus = 0;
        if (hipGetDevice(&dev) != hipSuccess || hipDeviceGetAttribute(&cus, hipDeviceAttributeMultiprocessorCount, dev) != hipSuccess) { g_grid = -1; return false; }
        if (hipFuncSetAttribute((const void*)mega_fwd, hipFuncAttributeMaxDynamicSharedMemorySize, LDS_BYTES) != hipSuccess) { fprintf(stderr, "hipFuncSetAttribute failed\n"); g_grid = -1; return false; }
        int per_cu = 0;
        if (hipOccupancyMaxActiveBlocksPerMultiprocessor(&per_cu, (const void*)mega_fwd, 512, LDS_BYTES) != hipSuccess || per_cu < 1) { fprintf(stderr, "occupancy query: %d\n", per_cu); }
        (void)hipGetLastError();
        if (ws_size < WS_END) { fprintf(stderr, "workspace too small: %zu < %zu\n", ws_size, (size_t)WS_END); g_grid = -1; return false; }
        g_grid = cus;
    }
    if (g_grid < 0) return false;
    Args a{};
    for (int i = 0; i < 19; ++i) a.in[i] = (const float*)d_in[i];
    a.out = (float*)d_out; a.ws = (unsigned char*)d_ws; a.ph_lo = lo; a.ph_hi = hi;
    hipLaunchKernelGGL(mega_fwd, dim3(g_grid), dim3(512), LDS_BYTES, stream, a);
    return true;
}
}
extern "C" void kernel_launch(void* const* d_in, const int* in_sizes, int n_in, void* d_out, int out_size, void* d_ws, size_t ws_size, hipStream_t stream) {
    (void)in_sizes; (void)n_in; (void)out_size;
    if (hipMemsetAsync((char*)d_ws + mk::WS_CTL, 0, mk::CTL_ZERO_BYTES, stream) != hipSuccess) { fprintf(stderr, "memset failed\n"); return; }
    mk::launch_phases(d_in, d_out, d_ws, ws_size, stream, 0, 11);
}
```

```cpp
#include <hip/hip_runtime.h>
#include <cstdio>
#include <cstdint>
#include <cmath>
#define LAS __attribute__((address_space(3)))
#define GAS __attribute__((address_space(1)))
typedef unsigned short bf16_t;
typedef short bf16x8 __attribute__((ext_vector_type(8)));
typedef short s16x4 __attribute__((ext_vector_type(4)));
typedef float f32x4 __attribute__((ext_vector_type(4)));
typedef float f32x16 __attribute__((ext_vector_type(16)));
typedef float f32x2 __attribute__((ext_vector_type(2)));
typedef unsigned u32x4 __attribute__((ext_vector_type(4)));
typedef unsigned u32x2 __attribute__((ext_vector_type(2)));

namespace mk {
constexpr int T = 16384, D = 1024, S = 4096, NE = 32, PLE = 256;
constexpr int NROWS_MAX = 73728;
constexpr float EPS = 1e-6f;
constexpr float LOG2E = 1.4426950408889634f;
constexpr float QSCALE = 0.125f * LOG2E;

__device__ __forceinline__ unsigned cvt_pk_bf16(float lo, float hi) { unsigned r; asm volatile("v_cvt_pk_bf16_f32 %0, %1, %2" : "=v"(r) : "v"(lo), "v"(hi)); return r; }
__device__ __forceinline__ float bf2f(unsigned short b) { return __uint_as_float(((unsigned)b) << 16); }
__device__ __forceinline__ float bflo(unsigned w) { return __uint_as_float(w << 16); }
__device__ __forceinline__ float bfhi(unsigned w) { return __uint_as_float(w & 0xffff0000u); }
__device__ __forceinline__ float wave_sum(float v) {
#pragma unroll
    for (int o = 1; o < 64; o <<= 1) v += __shfl_xor(v, o);
    return v;
}
__device__ __forceinline__ float sigmoidf_fast(float z) { return __builtin_amdgcn_rcpf(1.0f + __builtin_amdgcn_exp2f(-LOG2E * z)); }

constexpr int BM = 256, BK = 64, HALF = 128, HTB = HALF * BK * 2, STAGE_BYTES = 8 * HTB, NXCD = 8, WGM = 8;
__host__ __device__ __forceinline__ int lds_swz(int r) { return (r >> 1) & 7; }
__host__ __device__ __forceinline__ int lds_byte(int r, int chunk) { return r * 128 + ((chunk ^ lds_swz(r)) << 4); }
__host__ __device__ __forceinline__ void stage_rc(int b, int& R, int& C) { R = b >> 7; C = ((((b >> 4) & 7) ^ lds_swz(R)) << 3); }
__host__ __device__ __forceinline__ int perm32(int rho) { const int n = rho >> 4, i = rho & 15; return 8 * (i >> 2) + 4 * n + (i & 3); }

typedef int v8i32 __attribute__((ext_vector_type(8)));
__device__ __forceinline__ v8i32 cat8(bf16x8 lo, bf16x8 hi) { const u32x4 a = __builtin_bit_cast(u32x4, lo), b = __builtin_bit_cast(u32x4, hi);
    return (v8i32){(int)a.x, (int)a.y, (int)a.z, (int)a.w, (int)b.x, (int)b.y, (int)b.z, (int)b.w}; }
__device__ __forceinline__ unsigned pk_fp8x4(float a, float b, float c, float d) { int r = 0; r = __builtin_amdgcn_cvt_pk_fp8_f32(a, b, r, false); r = __builtin_amdgcn_cvt_pk_fp8_f32(c, d, r, true); return (unsigned)r; }
__device__ __forceinline__ f32x2 fp8x2_lo(unsigned w) { return __builtin_amdgcn_cvt_pk_f32_fp8((int)w, false); }
__device__ __forceinline__ f32x2 fp8x2_hi(unsigned w) { return __builtin_amdgcn_cvt_pk_f32_fp8((int)w, true); }
constexpr float WSCALE = 32.0f, WSCALE_INV = 1.0f / 32.0f;
struct Unit { int pm, pn; };
struct Gemm { const bf16_t* A; const bf16_t* Bt; int K; };

struct Order {
    int nM, nN, nwg, G, c; const LAS int* tile_e;
    __device__ __forceinline__ void init(int nM_, int nN_, int G_, int c_, const LAS int* te) { nM = nM_; nN = nN_; nwg = nM * nN; G = G_; c = c_; tile_e = te; }
    __device__ __forceinline__ bool next(int i, Unit& u) const {
        const long L = (long)i * G + c; if (L >= nwg) return false;
        int wgid = (int)L; { const int q = nwg / NXCD, r = nwg % NXCD, xcd = wgid % NXCD, off = wgid / NXCD; wgid = (xcd < r ? xcd * (q + 1) : r * (q + 1) + (xcd - r) * q) + off; }
        const int nig = WGM * nN, gid = wgid / nig, fm = gid * WGM, gsz = (nM - fm) < WGM ? (nM - fm) : WGM;
        u.pm = fm + ((wgid % nig) % gsz); u.pn = (wgid % nig) / gsz; return true;
    }
    __device__ __forceinline__ int b_tile(const Unit& u) const { return tile_e ? __builtin_amdgcn_readfirstlane(tile_e[u.pm]) * nN + u.pn : u.pn; }
    __device__ __forceinline__ int expert(const Unit& u) const { return tile_e ? __builtin_amdgcn_readfirstlane(tile_e[u.pm]) : 0; }
};

typedef f32x4 Acc[2][2][4][2];

template <class Epi, bool GATHER, bool FP8 = false>
__device__ __forceinline__ void gemm_phase(LAS unsigned char* lds, const Gemm g, const Order& S, const Epi& E, const LAS int* gtab) {
    const int tid = threadIdx.x, wid = __builtin_amdgcn_readfirstlane(tid >> 6), lane = tid & 63, wr = wid >> 2, wc = wid & 3, fr = lane & 15, fq = lane >> 4;
    const int K = g.K, nt = K / BK;
    unsigned voffB[2], vA0[2], vA1[2]; int Rr[2], Cc[2];
#pragma unroll
    for (int i = 0; i < 2; ++i) { int R, C; stage_rc(tid * 16 + i * 8192, R, C); const int Rb = Epi::PERM ? ((R & ~31) + perm32(R & 31)) : R;
        Rr[i] = R; Cc[i] = C; voffB[i] = (unsigned)(Rb * K + C) * 2u;
        if constexpr (!GATHER) { vA0[i] = (unsigned)(R * K + C) * 2u; vA1[i] = vA0[i]; } }
    const size_t kstep = (size_t)(BK * 2);
    const size_t hstep = (size_t)HALF * K * 2;
    const size_t hstepA = GATHER ? 0 : hstep;
    const size_t tstep = 2 * hstep;
    const unsigned ldsw = (unsigned)wid * 1024u;
    const int aoff0 = lds_byte(wr * 64 + fr, fq), aoff1 = lds_byte(wr * 64 + fr, fq + 4), boff0 = lds_byte(wc * 32 + fr, fq), boff1 = lds_byte(wc * 32 + fr, fq + 4);
#define PG8_SA(b, h) (((b) * 2 + (h)) * HTB)
#define PG8_SB(b, h) ((4 + (b) * 2 + (h)) * HTB)
#define PG8_STAGE(bufoff, gbase, voff) do { _Pragma("unroll") for (int _i = 0; _i < 2; ++_i) \
        __builtin_amdgcn_global_load_lds((const unsigned*)((const char*)(gbase) + (voff)[_i]), (LAS unsigned*)(lds + (bufoff) + ldsw + _i * 8192), 16, 0, 0); } while (0)
#define PG8_LD8(p0_, p1_) ({ typedef int v4i32_ __attribute__((ext_vector_type(4))); const v4i32_ lo_ = *(const LAS v4i32_*)(p0_), hi_ = *(const LAS v4i32_*)(p1_); __builtin_shufflevector(lo_, hi_, 0, 1, 2, 3, 4, 5, 6, 7); })
#define PG8_LDA(dst, b, h) do { if constexpr (FP8) { _Pragma("unroll") for (int m = 0; m < 4; ++m) dst##8[m] = PG8_LD8(lds + PG8_SA(b, h) + aoff0 + m * 2048, lds + PG8_SA(b, h) + aoff1 + m * 2048); } \
        else { _Pragma("unroll") for (int m = 0; m < 4; ++m) { dst[m][0] = *(const LAS bf16x8*)(lds + PG8_SA(b, h) + aoff0 + m * 2048); dst[m][1] = *(const LAS bf16x8*)(lds + PG8_SA(b, h) + aoff1 + m * 2048); } } } while (0)
#define PG8_LDB(dst, b, h) do { if constexpr (FP8) { _Pragma("unroll") for (int n = 0; n < 2; ++n) dst##8[n] = PG8_LD8(lds + PG8_SB(b, h) + boff0 + n * 2048, lds + PG8_SB(b, h) + boff1 + n * 2048); } \
        else { _Pragma("unroll") for (int n = 0; n < 2; ++n) { dst[n][0] = *(const LAS bf16x8*)(lds + PG8_SB(b, h) + boff0 + n * 2048); dst[n][1] = *(const LAS bf16x8*)(lds + PG8_SB(b, h) + boff1 + n * 2048); } } } while (0)
#define PG8_MMA(ai, bj, At, Bt) do { __builtin_amdgcn_s_setprio(1); _Pragma("unroll") for (int m = 0; m < 4; ++m) _Pragma("unroll") for (int n = 0; n < 2; ++n) { \
        if constexpr (FP8) { asm volatile("v_mfma_f32_16x16x128_f8f6f4 %0, %1, %2, %0" : "+v"(acc[ai][bj][m][n]) : "v"(Bt##8[n]), "v"(At##8[m])); } \
        else { _Pragma("unroll") for (int k = 0; k < 2; ++k) acc[ai][bj][m][n] = __builtin_amdgcn_mfma_f32_16x16x32_bf16(Bt[n][k], At[m][k], acc[ai][bj][m][n], 0, 0, 0); } } \
        __builtin_amdgcn_s_setprio(0); } while (0)
#define PG8_WAIT_V(n) asm volatile("s_waitcnt vmcnt(" #n ")" ::: "memory")
#define PG8_WAIT_L(n) asm volatile("s_waitcnt lgkmcnt(" #n ")" ::: "memory")
#define PG8_BAR __builtin_amdgcn_s_barrier()
#define PG8_SCHED __builtin_amdgcn_sched_barrier(0)
#define PG8_GLOAD(uidx) do { _Pragma("unroll") for (int _i = 0; _i < 2; ++_i) { vA0[_i] = (unsigned)gtab[(uidx) * 256 + Rr[_i]] + (unsigned)Cc[_i] * 2u; vA1[_i] = (unsigned)gtab[(uidx) * 256 + 128 + Rr[_i]] + (unsigned)Cc[_i] * 2u; } } while (0)
    Unit cur, nxt; int ui = 0;
    if (!S.next(0, cur)) return;
    Acc acc;
#pragma unroll
    for (int a = 0; a < 2; ++a)
#pragma unroll
        for (int b = 0; b < 2; ++b)
#pragma unroll
            for (int m = 0; m < 4; ++m)
#pragma unroll
                for (int n = 0; n < 2; ++n) acc[a][b][m][n] = (f32x4){0.f, 0.f, 0.f, 0.f};
    bf16x8 At[4][2], B0[2][2], B1[2][2]; v8i32 At8[4], B08[2], B18[2];
    if constexpr (GATHER) PG8_GLOAD(0);
    const char* cA = (const char*)g.A + (GATHER ? (size_t)0 : (size_t)cur.pm * tstep); const char* cB = (const char*)g.Bt + (size_t)S.b_tile(cur) * tstep;
    PG8_STAGE(PG8_SB(0, 0), cB, voffB); PG8_STAGE(PG8_SB(0, 1), cB + hstep, voffB); PG8_STAGE(PG8_SA(0, 0), cA, vA0); PG8_STAGE(PG8_SA(0, 1), cA + hstepA, vA1);
    if (wr == 1) PG8_BAR;
    PG8_WAIT_V(2); PG8_BAR;
    PG8_STAGE(PG8_SB(1, 0), cB + kstep, voffB); PG8_STAGE(PG8_SA(1, 0), cA + kstep, vA0); PG8_STAGE(PG8_SB(1, 1), cB + hstep + kstep, voffB);
    PG8_WAIT_V(6); PG8_BAR;
    for (;;) {
        const bool has_next = S.next(ui + 1, nxt);
        const char* nA = has_next ? (const char*)g.A + (GATHER ? (size_t)0 : (size_t)nxt.pm * tstep) : cA; const char* nB = has_next ? (const char*)g.Bt + (size_t)S.b_tile(nxt) * tstep : cB;
#pragma unroll 1
        for (int t = 0; t < nt; t += 2) {
            const bool last = (t == nt - 2);
            const char* a1 = cA + (size_t)(t + 1) * kstep;
            const char* a2 = last ? nA : cA + (size_t)(t + 2) * kstep; const char* b2 = last ? nB : cB + (size_t)(t + 2) * kstep;
            const char* a3 = a2 + kstep; const char* b3 = b2 + kstep;
            PG8_LDB(B0, 0, 0); PG8_LDB(B1, 0, 1); PG8_SCHED; PG8_LDA(At, 0, 0); PG8_STAGE(PG8_SA(1, 1), a1 + hstepA, vA1);
            PG8_WAIT_V(8); PG8_WAIT_L(0); PG8_BAR; PG8_MMA(0, 0, At, B0); PG8_MMA(0, 1, At, B1); PG8_BAR; PG8_SCHED;
            if constexpr (GATHER) { if (last && has_next) { PG8_GLOAD(ui + 1); } }
            PG8_LDA(At, 0, 1); PG8_STAGE(PG8_SB(0, 0), b2, voffB); PG8_STAGE(PG8_SB(0, 1), b2 + hstep, voffB); PG8_STAGE(PG8_SA(0, 0), a2, vA0);
            PG8_WAIT_V(8); PG8_WAIT_L(0); PG8_BAR; PG8_MMA(1, 0, At, B0); PG8_MMA(1, 1, At, B1); PG8_BAR; PG8_SCHED;
            PG8_LDB(B0, 1, 0); PG8_LDB(B1, 1, 1); PG8_SCHED; PG8_LDA(At, 1, 0); PG8_STAGE(PG8_SA(0, 1), a2 + hstepA, vA1);
            PG8_WAIT_V(8); PG8_WAIT_L(0); PG8_BAR; PG8_MMA(0, 0, At, B0); PG8_MMA(0, 1, At, B1); PG8_BAR; PG8_SCHED;
            PG8_LDA(At, 1, 1); PG8_STAGE(PG8_SB(1, 0), b3, voffB); PG8_STAGE(PG8_SB(1, 1), b3 + hstep, voffB); PG8_STAGE(PG8_SA(1, 0), a3, vA0);
            PG8_WAIT_V(8); PG8_WAIT_L(0); PG8_BAR; PG8_MMA(1, 0, At, B0); PG8_MMA(1, 1, At, B1); PG8_BAR; PG8_SCHED;
        }
        if (wr == 0) PG8_BAR;
        if constexpr (FP8) asm volatile("s_nop 15\n\ts_nop 15" ::: "memory");
        if constexpr (!Epi::AFTER_DRAIN) E(acc, cur, S, wr, wc, fr, fq);
        if (!has_next) break;
#pragma unroll
        for (int a = 0; a < 2; ++a)
#pragma unroll
            for (int b = 0; b < 2; ++b)
#pragma unroll
                for (int m = 0; m < 4; ++m)
#pragma unroll
                    for (int n = 0; n < 2; ++n) acc[a][b][m][n] = (f32x4){0.f, 0.f, 0.f, 0.f};
        cur = nxt; cA = nA; cB = nB; ++ui;
        if (wr == 1) PG8_BAR;
    }
    PG8_WAIT_V(0);
    PG8_BAR;
    if constexpr (Epi::AFTER_DRAIN) E.fused(acc, cur, wr, wc, fr, fq, lds, wid, lane);
#undef PG8_SA
#undef PG8_SB
#undef PG8_STAGE
#undef PG8_LDA
#undef PG8_LD8
#undef PG8_LDB
#undef PG8_MMA
#undef PG8_WAIT_V
#undef PG8_WAIT_L
#undef PG8_BAR
#undef PG8_SCHED
#undef PG8_GLOAD
}

struct EpiUQKV {
    static constexpr bool PERM = true, AFTER_DRAIN = false;
    bf16_t* base; size_t stride;
    __device__ __forceinline__ void operator()(const Acc& acc, const Unit& u, const Order&, int wr, int wc, int fr, int fq) const {
        bf16_t* O = base + (size_t)(u.pn >> 1) * stride;
        const int row0 = u.pm * BM + wr * 64 + fr, col0 = (u.pn & 1) * 256 + wc * 32 + 8 * fq;
#pragma unroll
        for (int ai = 0; ai < 2; ++ai)
#pragma unroll
            for (int m = 0; m < 4; ++m) { bf16_t* rowp = O + (size_t)(row0 + ai * HALF + m * 16) * 512 + col0;
#pragma unroll
                for (int bj = 0; bj < 2; ++bj) { const f32x4 v0 = acc[ai][bj][m][0], v1 = acc[ai][bj][m][1];
                    u32x4 w; w.x = cvt_pk_bf16(v0[0], v0[1]); w.y = cvt_pk_bf16(v0[2], v0[3]); w.z = cvt_pk_bf16(v1[0], v1[1]); w.w = cvt_pk_bf16(v1[2], v1[3]);
                    *(u32x4*)(rowp + bj * HALF) = w; } }
    }
};
struct EpiBf16 {
    static constexpr bool PERM = true, AFTER_DRAIN = false;
    bf16_t* O; int ldc;
    __device__ __forceinline__ void operator()(const Acc& acc, const Unit& u, const Order&, int wr, int wc, int fr, int fq) const {
        const int row0 = u.pm * BM + wr * 64 + fr, col0 = u.pn * BM + wc * 32 + 8 * fq;
#pragma unroll
        for (int ai = 0; ai < 2; ++ai)
#pragma unroll
            for (int m = 0; m < 4; ++m) { bf16_t* rowp = O + (size_t)(row0 + ai * HALF + m * 16) * ldc + col0;
#pragma unroll
                for (int bj = 0; bj < 2; ++bj) { const f32x4 v0 = acc[ai][bj][m][0], v1 = acc[ai][bj][m][1];
                    u32x4 w; w.x = cvt_pk_bf16(v0[0], v0[1]); w.y = cvt_pk_bf16(v0[2], v0[3]); w.z = cvt_pk_bf16(v1[0], v1[1]); w.w = cvt_pk_bf16(v1[2], v1[3]);
                    *(u32x4*)(rowp + bj * HALF) = w; } }
    }
};
struct EpiResBf16 {
    static constexpr bool PERM = true, AFTER_DRAIN = false;
    const float* base; bf16_t* out;
    __device__ __forceinline__ void operator()(const Acc& acc, const Unit& u, const Order&, int wr, int wc, int fr, int fq) const {
        const int row0 = u.pm * BM + wr * 64 + fr, col0 = u.pn * BM + wc * 32 + 8 * fq;
#pragma unroll
        for (int ai = 0; ai < 2; ++ai)
#pragma unroll
            for (int m = 0; m < 4; ++m) { const size_t off = (size_t)(row0 + ai * HALF + m * 16) * D + col0;
#pragma unroll
                for (int bj = 0; bj < 2; ++bj) { const f32x4 b0 = *(const f32x4*)(base + off + bj * HALF), b1 = *(const f32x4*)(base + off + bj * HALF + 4);
                    const f32x4 v0 = b0 + acc[ai][bj][m][0], v1 = b1 + acc[ai][bj][m][1];
                    u32x4 w; w.x = cvt_pk_bf16(v0[0], v0[1]); w.y = cvt_pk_bf16(v0[2], v0[3]); w.z = cvt_pk_bf16(v1[0], v1[1]); w.w = cvt_pk_bf16(v1[2], v1[3]);
                    *(u32x4*)(out + off + bj * HALF) = w; } }
    }
};
struct EpiResF32 {
    static constexpr bool PERM = false, AFTER_DRAIN = false;
    const float* base; float* out;
    __device__ __forceinline__ void operator()(const Acc& acc, const Unit& u, const Order&, int wr, int wc, int fr, int fq) const {
        const int row0 = u.pm * BM + wr * 64 + fr, col0 = u.pn * BM + wc * 32 + 4 * fq;
#pragma unroll
        for (int ai = 0; ai < 2; ++ai)
#pragma unroll
            for (int m = 0; m < 4; ++m) { const size_t off = (size_t)(row0 + ai * HALF + m * 16) * D + col0;
#pragma unroll
                for (int bj = 0; bj < 2; ++bj)
#pragma unroll
                    for (int n = 0; n < 2; ++n) { const f32x4 b = *(const f32x4*)(base + off + bj * HALF + n * 16); *(f32x4*)(out + off + bj * HALF + n * 16) = b + acc[ai][bj][m][n]; } }
    }
};
struct EpiSwiGLU {
    static constexpr bool PERM = true, AFTER_DRAIN = false;
    unsigned char* H; const float* bgu;
    __device__ __forceinline__ void operator()(const Acc& acc, const Unit& u, const Order& S, int wr, int wc, int fr, int fq) const {
        const int e = S.expert(u);
        const int row0 = u.pm * BM + wr * 64 + fr, j0 = u.pn * 128 + wc * 32 + 8 * fq;
        const float* bg = bgu + (size_t)e * 2048 + j0; const float* bu = bg + 1024;
        const f32x4 bg0 = *(const f32x4*)bg, bg1 = *(const f32x4*)(bg + 4), bu0 = *(const f32x4*)bu, bu1 = *(const f32x4*)(bu + 4);
#pragma unroll
        for (int ai = 0; ai < 2; ++ai)
#pragma unroll
            for (int m = 0; m < 4; ++m) {
                float hv[8];
#pragma unroll
                for (int n = 0; n < 2; ++n) { const f32x4 gq = acc[ai][0][m][n] * WSCALE_INV + (n ? bg1 : bg0), uq = acc[ai][1][m][n] * WSCALE_INV + (n ? bu1 : bu0);
#pragma unroll
                    for (int x2 = 0; x2 < 2; ++x2) {
                        f32x2 gg = (f32x2){gq[2 * x2], gq[2 * x2 + 1]}, uu = (f32x2){uq[2 * x2], uq[2 * x2 + 1]};
                        gg = __builtin_elementwise_min(gg, (f32x2){7.0f, 7.0f}); uu = __builtin_elementwise_min(__builtin_elementwise_max(uu, (f32x2){-7.0f, -7.0f}), (f32x2){7.0f, 7.0f});
                        const f32x2 tz = gg * (-1.702f * LOG2E); f32x2 den; den.x = __builtin_amdgcn_exp2f(tz.x); den.y = __builtin_amdgcn_exp2f(tz.y); den = den + 1.0f;
                        f32x2 rc; rc.x = __builtin_amdgcn_rcpf(den.x); rc.y = __builtin_amdgcn_rcpf(den.y);
                        const f32x2 hh = ((uu + 1.0f) * gg) * rc; hv[n * 4 + 2 * x2] = hh.x; hv[n * 4 + 2 * x2 + 1] = hh.y; } }
                u32x2 w; w.x = pk_fp8x4(hv[0], hv[1], hv[2], hv[3]); w.y = pk_fp8x4(hv[4], hv[5], hv[6], hv[7]);
                *(u32x2*)(H + (size_t)(row0 + ai * HALF + m * 16) * 1024 + j0) = w; }
    }
};
struct EpiDown {
    static constexpr bool PERM = true, AFTER_DRAIN = false;
    unsigned char* Y; const float* bdn;
    __device__ __forceinline__ void operator()(const Acc& acc, const Unit& u, const Order& S, int wr, int wc, int fr, int fq) const {
        const int e = S.expert(u);
        const int row0 = u.pm * BM + wr * 64 + fr, col0 = u.pn * BM + wc * 32 + 8 * fq;
        const float* bp = bdn + (size_t)e * 1024 + col0;
#pragma unroll
        for (int bj = 0; bj < 2; ++bj) { const f32x4 b0 = *(const f32x4*)(bp + bj * HALF), b1 = *(const f32x4*)(bp + bj * HALF + 4);
#pragma unroll
            for (int ai = 0; ai < 2; ++ai)
#pragma unroll
                for (int m = 0; m < 4; ++m) { const f32x4 v0 = acc[ai][bj][m][0] * WSCALE_INV + b0, v1 = acc[ai][bj][m][1] * WSCALE_INV + b1;
                    u32x2 w; w.x = pk_fp8x4(v0[0], v0[1], v0[2], v0[3]); w.y = pk_fp8x4(v1[0], v1[1], v1[2], v1[3]);
                    *(u32x2*)(Y + (size_t)(row0 + ai * HALF + m * 16) * 1024 + col0 + bj * HALF) = w; } }
    }
};
struct EpiPle {
    static constexpr bool PERM = false, AFTER_DRAIN = false;
    const bf16_t* x2; const bf16_t* pp; float* out; float* rowss;
    __device__ __forceinline__ void operator()(const Acc& acc, const Unit& u, const Order&, int wr, int wc, int fr, int fq) const {
        const int row0 = u.pm * BM + wr * 64 + fr, col0 = u.pn * BM + wc * 32 + 4 * fq;
#pragma unroll
        for (int ai = 0; ai < 2; ++ai)
#pragma unroll
            for (int m = 0; m < 4; ++m) { const int row = row0 + ai * HALF + m * 16; const size_t off = (size_t)row * D + col0; float ss = 0.f;
#pragma unroll
                for (int bj = 0; bj < 2; ++bj)
#pragma unroll
                    for (int n = 0; n < 2; ++n) { const size_t o2 = off + bj * HALF + n * 16; const u32x2 xw = *(const u32x2*)(x2 + o2); const f32x4 xb = (f32x4){bflo(xw.x), bfhi(xw.x), bflo(xw.y), bfhi(xw.y)}; const u32x2 pw = *(const u32x2*)(pp + o2);
                        const f32x4 a = acc[ai][bj][m][n]; f32x4 r;
                        r[0] = xb[0] + bflo(pw.x) * sigmoidf_fast(a[0] * WSCALE_INV); r[1] = xb[1] + bfhi(pw.x) * sigmoidf_fast(a[1] * WSCALE_INV);
                        r[2] = xb[2] + bflo(pw.y) * sigmoidf_fast(a[2] * WSCALE_INV); r[3] = xb[3] + bfhi(pw.y) * sigmoidf_fast(a[3] * WSCALE_INV);
                        ss += (r[0] * r[0] + r[1] * r[1]) + (r[2] * r[2] + r[3] * r[3]);
                        *(f32x4*)(out + o2) = r; }
                ss += __shfl_xor(ss, 16); ss += __shfl_xor(ss, 32);
                if (fq == 0) atomicAdd(rowss + row, ss); }
    }
};
struct EpiPleNorm {
    static constexpr bool PERM = false, AFTER_DRAIN = true;
    const bf16_t* x2; const bf16_t* pp; float* out; const float* gfin; float* xbuf; unsigned* cnt; unsigned* tmo; const unsigned long long* ts;
    __device__ __forceinline__ void fused(Acc& acc, const Unit& u, int wr, int wc, int fr, int fq, LAS unsigned char* lds, int wid, int lane) const {
        LAS float* P = (LAS float*)lds;
        LAS float* Sr = (LAS float*)(lds + 4096);
        LAS unsigned* flag = (LAS unsigned*)(lds + 4096 + 1024);
        const int row0 = u.pm * BM + wr * 64 + fr, col0 = u.pn * BM + wc * 32 + 4 * fq;
#pragma unroll
        for (int ai = 0; ai < 2; ++ai)
#pragma unroll
            for (int m = 0; m < 4; ++m) { const int row = row0 + ai * HALF + m * 16; const size_t off = (size_t)row * D + col0; float ss = 0.f;
#pragma unroll
                for (int bj = 0; bj < 2; ++bj)
#pragma unroll
                    for (int n = 0; n < 2; ++n) { const size_t o2 = off + bj * HALF + n * 16; const u32x2 xw = *(const u32x2*)(x2 + o2); const f32x4 xb = (f32x4){bflo(xw.x), bfhi(xw.x), bflo(xw.y), bfhi(xw.y)}; const u32x2 pw = *(const u32x2*)(pp + o2);
                        const f32x4 a = acc[ai][bj][m][n]; f32x4 r;
                        r[0] = xb[0] + bflo(pw.x) * sigmoidf_fast(a[0] * WSCALE_INV); r[1] = xb[1] + bfhi(pw.x) * sigmoidf_fast(a[1] * WSCALE_INV);
                        r[2] = xb[2] + bflo(pw.y) * sigmoidf_fast(a[2] * WSCALE_INV); r[3] = xb[3] + bfhi(pw.y) * sigmoidf_fast(a[3] * WSCALE_INV);
                        ss += (r[0] * r[0] + r[1] * r[1]) + (r[2] * r[2] + r[3] * r[3]);
                        acc[ai][bj][m][n] = r; }
                ss += __shfl_xor(ss, 16); ss += __shfl_xor(ss, 32);
                if (fq == 0) P[(ai * HALF + wr * 64 + m * 16 + fr) * 4 + wc] = ss;
                if (m & 1) asm volatile("" ::: "memory"); }
        asm volatile("s_waitcnt lgkmcnt(0)" ::: "memory"); __builtin_amdgcn_s_barrier(); asm volatile("" ::: "memory");
        const int row = wid * 32 + (lane & 31);
        if (lane < 32) { const float tot = (P[row * 4 + 0] + P[row * 4 + 1]) + (P[row * 4 + 2] + P[row * 4 + 3]);
            __hip_atomic_store(xbuf + ((size_t)(u.pm * BM + row) * 4 + u.pn), tot, __ATOMIC_RELAXED, __HIP_MEMORY_SCOPE_AGENT); }
        asm volatile("s_waitcnt vmcnt(0)" ::: "memory");
        if (lane == 0) __hip_atomic_fetch_add(cnt + 64 * u.pm, 1u, __ATOMIC_RELAXED, __HIP_MEMORY_SCOPE_AGENT);
        if (wid == 0) {
            bool dead = false; const unsigned long long t0 = __builtin_amdgcn_s_memrealtime();
            for (;;) {
                if ((unsigned)__builtin_amdgcn_readfirstlane(__hip_atomic_load(cnt + 64 * u.pm, __ATOMIC_RELAXED, __HIP_MEMORY_SCOPE_AGENT)) >= 32u) break;
                if (__builtin_amdgcn_s_memrealtime() - t0 > 2000000ull) { if (lane == 0) __hip_atomic_store(tmo, 1u, __ATOMIC_RELAXED, __HIP_MEMORY_SCOPE_AGENT); dead = true; break; }
                __builtin_amdgcn_s_sleep(2);
            }
            __builtin_amdgcn_fence(__ATOMIC_ACQUIRE, "agent");
            if (lane == 0) flag[0] = dead ? 1u : 0u;
        }
        asm volatile("s_waitcnt vmcnt(0) lgkmcnt(0)" ::: "memory"); __builtin_amdgcn_s_barrier(); asm volatile("" ::: "memory");
        const bool bad = flag[0] != 0u;
        if (lane < 32) { const float* slot = xbuf + (size_t)(u.pm * BM + row) * 4; float q = 0.f;
#pragma unroll
            for (int t = 0; t < 4; ++t) q += __hip_atomic_load(slot + t, __ATOMIC_RELAXED, __HIP_MEMORY_SCOPE_AGENT);
            Sr[row] = 1.0f / sqrtf(q * (1.0f / D) + EPS); }
        asm volatile("s_waitcnt lgkmcnt(0)" ::: "memory"); __builtin_amdgcn_s_barrier(); asm volatile("" ::: "memory");
        const float qnan = __builtin_nanf("");
        float pscale = 1.0f, pspike = 0.0f;
#if defined(PROBE_A)
        pscale = 1.0f + (float)(ts[PROBE_A + 1] - ts[PROBE_A]) * 2e-6f;
#endif
#pragma unroll
        for (int bj = 0; bj < 2; ++bj)
#pragma unroll
            for (int n = 0; n < 2; ++n) { const f32x4 gv = *(const f32x4*)(gfin + col0 + bj * HALF + n * 16) * pscale;
#pragma unroll
                for (int ai = 0; ai < 2; ++ai)
#pragma unroll
                    for (int m = 0; m < 4; ++m) { const int rl = ai * HALF + wr * 64 + m * 16 + fr; const float rs = Sr[rl];
                        f32x4 o = acc[ai][bj][m][n] * rs * gv; if (bad) o = (f32x4){qnan, qnan, qnan, qnan};
#if defined(PROBE_A)
                        if (u.pm * BM + rl == 0 && col0 + bj * HALF + n * 16 == 0) o[0] += pspike;
#endif
                        *(f32x4*)(out + (size_t)(u.pm * BM + rl) * D + col0 + bj * HALF + n * 16) = o; } }
    }
};
}
namespace mk {
constexpr size_t MiB = 1u << 20;
constexpr size_t WS_CTL = 0, CTL_ZERO_BYTES = 1 * MiB;
constexpr int CW_TMO = 0, CW_CNT = 16384, CW_BAR = 4096;
constexpr size_t WS_ROWSS = 512 * 1024;
constexpr int CW_PANEL = 32768;
constexpr size_t WS_XBUF = 1 * MiB + 256 * 1024;
constexpr size_t WS_BIAS = 1 * MiB;
constexpr size_t WS_WPT = 1 * MiB + 64 * 1024;
constexpr size_t WS_WT_PP = 2 * MiB;
constexpr size_t WS_RTAB = 3 * MiB;
constexpr size_t WS_WT_IN = 4 * MiB;
constexpr size_t WS_WT_OUT = 8 * MiB;
constexpr size_t WS_WT_PG = 10 * MiB;
constexpr size_t WS_LIST = 12 * MiB;
constexpr size_t WS_TOKINFO = 14 * MiB;
constexpr size_t WS_LSE = 15 * MiB;
constexpr size_t WS_PB = 17 * MiB;
constexpr size_t WS_BTILE = 26 * MiB;
constexpr size_t WS_WT_GU = 32 * MiB;
constexpr size_t WS_XN8 = 96 * MiB;
constexpr size_t WS_WT_DN = 112 * MiB;
constexpr size_t WS_XN = 144 * MiB;
constexpr size_t WS_UQKV = 272 * MiB;
constexpr size_t WS_OB = 336 * MiB;
constexpr size_t WS_MIX = 384 * MiB;
constexpr size_t WS_PPB = 176 * MiB;
constexpr size_t WS_X1 = 208 * MiB;
constexpr size_t WS_X2 = 416 * MiB;
constexpr size_t WS_H = 272 * MiB;
constexpr size_t WS_Y = 344 * MiB;
constexpr size_t WS_END = 448 * MiB;

constexpr int RING_BYTES = 131072;
constexpr int L_MISC = RING_BYTES;
constexpr int L_CNT = L_MISC + 256;
constexpr int L_BASE = L_CNT + 128;
constexpr int L_TILE_E = L_BASE + 256;
constexpr int L_GTAB = L_TILE_E + 1280;
constexpr int MAXU = 12;
constexpr int LDS_BYTES = 163840;
static_assert(L_GTAB + MAXU * 1024 <= LDS_BYTES, "LDS map");

typedef GAS unsigned gu32;
#define RLX_AGENT __ATOMIC_RELAXED, __HIP_MEMORY_SCOPE_AGENT
#define LDS_WAIT() asm volatile("s_waitcnt lgkmcnt(0)" ::: "memory")
#define VM_WAIT() asm volatile("s_waitcnt vmcnt(0)" ::: "memory")

#define XB_TMO      128
#define XB_XCNT(j)  (256  + 64 * (j))
#define XB_XSUB(j)  (1280 + 64 * (j))
#define XB_XGEN(j)  (2304 + 64 * (j))
#define XB_TOP      3328
#define XB_TOPGEN   3392
#define XCD_BAR_WORDS 3456
#define XB_SPIN_CAP (1u << 18)
__device__ __forceinline__ unsigned xb_ld(unsigned* p)              { return __hip_atomic_load(p, __ATOMIC_RELAXED, __HIP_MEMORY_SCOPE_AGENT); }
__device__ __forceinline__ unsigned xb_add(unsigned* p, unsigned v) { return __hip_atomic_fetch_add(p, v, __ATOMIC_RELAXED, __HIP_MEMORY_SCOPE_AGENT); }
__device__ __forceinline__ unsigned xb_xcc_id() { return (unsigned)__builtin_amdgcn_s_getreg((3 << 11) | 20) & 0xFu; }
#define XB_SPIN(cond, bar) do { unsigned _sp = 0; while (cond) { __builtin_amdgcn_s_sleep(1); \
    if ((++_sp & 255u) == 0u) { if (xb_ld(&(bar)[XB_TMO])) break; if (_sp > XB_SPIN_CAP) { atomicAdd(&(bar)[XB_TMO], 1u); break; } } } } while (0)
struct XcdBarrier { unsigned* bar; unsigned x; volatile LAS unsigned* st; };
__device__ __forceinline__ XcdBarrier xcd_barrier_post(unsigned* bar, volatile LAS unsigned* st) {
    XcdBarrier b; b.bar = bar; b.x = xb_xcc_id(); b.st = st;
    if (threadIdx.x == 0) (void)xb_add(&bar[XB_XCNT(b.x)], 1u);
    return b;
}
__device__ __forceinline__ void xcd_barrier_complete(unsigned* bar, unsigned x, unsigned& nloc, unsigned& nx) {
    const unsigned G = gridDim.x * gridDim.y * gridDim.z;
    unsigned sum, cnt, mine, sp = 0u;
    for (;;) {
        sum = 0u; cnt = 0u; mine = 0u;
#pragma unroll
        for (unsigned j = 0; j < 16; ++j) { const unsigned c = xb_ld(&bar[XB_XCNT(j)]); sum += c; cnt += (c > 0u) ? 1u : 0u; mine = (j == x) ? c : mine; }
        if (sum == G) break;
        __builtin_amdgcn_s_sleep(1);
        if ((++sp & 255u) == 0u) { if (xb_ld(&bar[XB_TMO])) break; if (sp > XB_SPIN_CAP) { atomicAdd(&bar[XB_TMO], 1u); break; } }
    }
    nloc = mine > 0u ? mine : 1u; nx = cnt > 0u ? cnt : 1u;
}
__device__ __forceinline__ void xcd_barrier(const XcdBarrier& b) {
    asm volatile("s_waitcnt vmcnt(0)" ::: "memory");
    __syncthreads();
    if (threadIdx.x == 0) {
        unsigned* bar = b.bar;
        __builtin_amdgcn_s_waitcnt(0);
        unsigned nloc = b.st[0], nx = b.st[1];
        if (nloc == 0u) { xcd_barrier_complete(bar, b.x, nloc, nx); b.st[0] = nloc; b.st[1] = nx; }
        const unsigned old = xb_add(&bar[XB_XSUB(b.x)], 1u);
        const unsigned gen = old / nloc;
        if (old + 1u == (gen + 1u) * nloc) {
            __builtin_amdgcn_fence(__ATOMIC_RELEASE, "agent");
            asm volatile("s_waitcnt vmcnt(0)" ::: "memory");
            const unsigned og = xb_add(&bar[XB_TOP], 1u);
            const unsigned tg = og / nx;
            if (og + 1u == (tg + 1u) * nx) xb_add(&bar[XB_TOPGEN], 1u);
            else XB_SPIN(xb_ld(&bar[XB_TOPGEN]) == tg, bar);
            __builtin_amdgcn_fence(__ATOMIC_ACQUIRE, "agent");
            xb_add(&bar[XB_XGEN(b.x)], 1u);
            asm volatile("s_waitcnt vmcnt(0)" ::: "memory");
        } else {
            XB_SPIN(xb_ld(&bar[XB_XGEN(b.x)]) == gen, bar);
            __builtin_amdgcn_fence(__ATOMIC_ACQUIRE, "agent");
            asm volatile("s_waitcnt vmcnt(0)" ::: "memory");
        }
    }
    __syncthreads();
}

struct Args { const float* in[19]; float* out; unsigned char* ws; int ph_lo, ph_hi; };
struct Frame {
    LAS unsigned char* lds;
    int tid, lane, wave, vcu, G;
    unsigned char* ws;
    float* out;
};
__device__ __forceinline__ unsigned f2bf(float f) { unsigned u = __builtin_bit_cast(unsigned, f); return (u + 0x7fffu + ((u >> 16) & 1u)) >> 16; }
__device__ __forceinline__ unsigned pk2(float lo, float hi) { return f2bf(lo) | (f2bf(hi) << 16); }

__device__ __forceinline__ void p0_transpose_item(const float* W, int K, int N, bf16_t* WT, int k0, int n0, int drow0, LAS float* scr, int lane, float scale = 1.0f) {
#pragma unroll 8
    for (int i = 0; i < 32; ++i) { const int kk = 2 * i + (lane >> 5); scr[kk * 33 + (lane & 31)] = W[(size_t)(k0 + kk) * N + n0 + (lane & 31)] * scale; }
    LDS_WAIT(); asm volatile("" ::: "memory");
    const int c = lane & 7;
#pragma unroll
    for (int j = 0; j < 4; ++j) { const int n = (lane >> 3) + 8 * j; const LAS float* s = scr + (8 * c) * 33 + n;
        u32x4 o; o.x = pk2(s[0 * 33], s[1 * 33]); o.y = pk2(s[2 * 33], s[3 * 33]); o.z = pk2(s[4 * 33], s[5 * 33]); o.w = pk2(s[6 * 33], s[7 * 33]);
        *(GAS u32x4*)(WT + (size_t)(drow0 + n) * K + k0 + 8 * c) = o; }
    LDS_WAIT(); asm volatile("" ::: "memory");
}
__device__ __forceinline__ int crow(int r, int hi) { return (r & 3) + 8 * (r >> 2) + 4 * hi; }
__device__ __forceinline__ int t5_bucket(int dist) {
    if (dist < 16) return dist;
    const float n = (float)dist;
    int large = 16 + (int)(logf(n / 16.0f) / logf(128.0f) * 16.0f);
    return large < 31 ? large : 31;
}
__device__ __forceinline__ void rms_row_to_bf16(const float* xrow, const float* g, bf16_t* orow, int lane) {
    const f32x4* xr = (const f32x4*)xrow + lane; const f32x4* gr = (const f32x4*)g + lane;
    f32x4 v[4]; float s = 0.f;
#pragma unroll
    for (int j = 0; j < 4; ++j) { v[j] = xr[64 * j]; s += (v[j].x * v[j].x + v[j].y * v[j].y) + (v[j].z * v[j].z + v[j].w * v[j].w); }
    const float rstd = 1.f / sqrtf(wave_sum(s) * (1.f / D) + EPS);
    unsigned long long* o8 = (unsigned long long*)orow + lane;
#pragma unroll
    for (int j = 0; j < 4; ++j) { const f32x4 gg = gr[64 * j];
        o8[64 * j] = (unsigned long long)pk2(v[j].x * rstd * gg.x, v[j].y * rstd * gg.y) | ((unsigned long long)pk2(v[j].z * rstd * gg.z, v[j].w * rstd * gg.w) << 32); }
}
struct TItem { const float* W; bf16_t* WT; int K, N, k0, n0, drow0; float scale; int q; };
__device__ __forceinline__ TItem p0_decode(Frame& F, const Args& A, int r) {
    constexpr int I_GU = 32 * 16 * 32, I_DN = 32 * 16 * 16, I_IN = 16 * 32, I_OUT = 16 * 16, I_PG = 16 * 16, I_PP = 4 * 16;
    TItem t; t.scale = 1.0f; t.q = 0;
    if (r < I_DN) { const int e = r / 256, q = r % 256, kb = q / 16, nb = q % 16;
        t.W = A.in[13] + (size_t)e * 1024 * 1024; t.WT = (bf16_t*)(F.ws + WS_WT_DN + (size_t)e * 1024 * 1024); t.scale = WSCALE; t.K = 1024; t.N = 1024; t.k0 = kb * 64; t.n0 = nb * 64; t.drow0 = nb * 64; t.q = 1; return t; } r -= I_DN;
    if (r < I_OUT) { const int kb = r / 16, nb = r % 16; t.W = A.in[7]; t.WT = (bf16_t*)(F.ws + WS_WT_OUT); t.K = 1024; t.N = 1024; t.k0 = kb * 64; t.n0 = nb * 64; t.drow0 = nb * 64; return t; } r -= I_OUT;
    if (r < I_PG) { const int kb = r / 16, nb = r % 16; t.W = A.in[16]; t.WT = (bf16_t*)(F.ws + WS_WT_PG); t.K = 1024; t.N = 1024; t.k0 = kb * 64; t.n0 = nb * 64; t.drow0 = nb * 64; t.scale = WSCALE; t.q = 1; return t; } r -= I_PG;
    if (r < I_GU) { const int e = r / 512, q = r % 512, kb = q / 32, nb = q % 32, n0 = nb * 64, half = n0 >> 10, j = n0 & 1023, pn = j >> 7, jj = j & 127;
        t.W = A.in[11] + (size_t)e * 1024 * 2048; t.WT = (bf16_t*)(F.ws + WS_WT_GU + (size_t)e * 2048 * 1024); t.scale = WSCALE; t.K = 1024; t.N = 2048; t.k0 = kb * 64; t.n0 = n0; t.drow0 = pn * 256 + half * 128 + jj; t.q = 1; return t; } r -= I_GU;
    if (r < I_IN) { const int kb = r / 32, nb = r % 32; t.W = A.in[3]; t.WT = (bf16_t*)(F.ws + WS_WT_IN); t.K = 1024; t.N = 2048; t.k0 = kb * 64; t.n0 = nb * 64; t.drow0 = nb * 64; t.scale = (nb >= 8 && nb < 16) ? QSCALE : 1.0f; return t; } r -= I_IN;
    if (r < I_PP) { const int kb = r / 16, nb = r % 16; t.W = A.in[17]; t.WT = (bf16_t*)(F.ws + WS_WT_PP); t.K = 256; t.N = 1024; t.k0 = kb * 64; t.n0 = nb * 64; t.drow0 = nb * 64; return t; } r -= I_PP;
    { const int g = r / 4, q = r % 4, kb = q / 2, nb = q % 2; t.W = A.in[4] + (size_t)g * 128 * 128; t.WT = (bf16_t*)(F.ws + WS_WPT) + (size_t)g * 128 * 128; t.K = 128; t.N = 128; t.k0 = kb * 64; t.n0 = nb * 64; t.drow0 = nb * 64; return t; }
}
template <int MODE>
__device__ __forceinline__ void p0_probe(Frame& F, const Args& A) {
    const int gw = F.vcu * 8 + F.wave, NGW = F.G * 8, lane = F.lane;
    if constexpr (MODE == 2) {
        const f32x4* src = (const f32x4*)A.in[11]; const size_t n4 = (size_t)32 * 1024 * 2048 / 4 + (size_t)32 * 1024 * 1024 / 4;
        const f32x4* src2 = (const f32x4*)A.in[13];
        f32x4 acc = {0.f, 0.f, 0.f, 0.f};
        for (size_t blk = gw; blk < n4 / 1024; blk += NGW) {
            const size_t off = blk * 1024; const f32x4* p = off < (size_t)32 * 1024 * 2048 / 4 ? src + off : src2 + (off - (size_t)32 * 1024 * 2048 / 4);
#pragma unroll
            for (int i = 0; i < 16; ++i) acc += p[lane + 64 * i];
        }
        if (acc[0] == 123.456f) ((float*)(F.ws + WS_H))[lane] = acc[1] + acc[2] + acc[3];
    }
}
constexpr int P0_LATE_ITEMS = 32 * 16 * 32 + 32 * 16 * 16 + 16 * 16 + 16 * 16, P0_EARLY_ITEMS = 16 * 32 + 4 * 16 + 16;
__device__ __forceinline__ void convert_items(Frame& F, const Args& A, int item0, int nitems, int gw, int NGW, LAS float* scr, bool nostore = false) {
    const int lane = F.lane; const int NITEMS = item0 + nitems;
    const int l4 = lane >> 4, l15 = lane & 15, c8 = lane & 7, nl = lane >> 3;
#define CV_LOAD(R, TI) do { _Pragma("unroll") for (int i = 0; i < 16; ++i) R[i] = __builtin_nontemporal_load((const f32x4*)((TI).W + (size_t)((TI).k0 + 4 * i + l4) * (TI).N + (TI).n0 + 4 * l15)); } while (0)
#define CV_PROCESS(R, TI, HASN, TN) do { \
        _Pragma("unroll") for (int i = 0; i < 16; ++i) { const int kk = 4 * i + l4; const f32x4 v = R[i] * (TI).scale; \
            scr[kk * 65 + 4 * l15 + 0] = v[0]; scr[kk * 65 + 4 * l15 + 1] = v[1]; scr[kk * 65 + 4 * l15 + 2] = v[2]; scr[kk * 65 + 4 * l15 + 3] = v[3]; } \
        if (HASN) CV_LOAD(R, TN); \
        LDS_WAIT(); asm volatile("" ::: "memory"); \
        if ((TI).q) {         \
            const int c4 = lane & 3, n4 = lane >> 2; unsigned char* W8 = (unsigned char*)(TI).WT; \
            _Pragma("unroll") for (int j = 0; j < 4; ++j) { const int n = n4 + 16 * j; const LAS float* sp = scr + (16 * c4) * 65 + n; \
                u32x4 o; o.x = pk_fp8x4(sp[0 * 65], sp[1 * 65], sp[2 * 65], sp[3 * 65]); o.y = pk_fp8x4(sp[4 * 65], sp[5 * 65], sp[6 * 65], sp[7 * 65]); \
                o.z = pk_fp8x4(sp[8 * 65], sp[9 * 65], sp[10 * 65], sp[11 * 65]); o.w = pk_fp8x4(sp[12 * 65], sp[13 * 65], sp[14 * 65], sp[15 * 65]); \
                if (!nostore) *(GAS u32x4*)(W8 + (size_t)((TI).drow0 + n) * (TI).K + (TI).k0 + 16 * c4) = o; else asm volatile("" :: "v"(o)); } \
        } else { \
            _Pragma("unroll") for (int j = 0; j < 8; ++j) { const int n = nl + 8 * j; const LAS float* sp = scr + (8 * c8) * 65 + n; \
                u32x4 o; o.x = pk2(sp[0 * 65], sp[1 * 65]); o.y = pk2(sp[2 * 65], sp[3 * 65]); o.z = pk2(sp[4 * 65], sp[5 * 65]); o.w = pk2(sp[6 * 65], sp[7 * 65]); \
                if (!nostore) *(GAS u32x4*)((TI).WT + (size_t)((TI).drow0 + n) * (TI).K + (TI).k0 + 8 * c8) = o; else asm volatile("" :: "v"(o)); } \
        } \
        LDS_WAIT(); asm volatile("" ::: "memory"); } while (0)
    f32x4 rA[16], rB[16];
    int itA = item0 + gw, itB = itA + NGW; bool hA = itA < NITEMS, hB = itB < NITEMS; TItem tA, tB;
    if (hA) { tA = p0_decode(F, A, itA); CV_LOAD(rA, tA); } else { tA = p0_decode(F, A, item0); }
    if (hB) { tB = p0_decode(F, A, itB); CV_LOAD(rB, tB); } else { tB = tA; }
    while (hA) {
        const int itA2 = itA + 2 * NGW; const bool hA2 = itA2 < NITEMS; TItem tA2 = tA; if (hA2) tA2 = p0_decode(F, A, itA2);
        CV_PROCESS(rA, tA, hA2, tA2);
        if (!hB) break;
        const int itB2 = itB + 2 * NGW; const bool hB2 = itB2 < NITEMS; TItem tB2 = tB; if (hB2) tB2 = p0_decode(F, A, itB2);
        CV_PROCESS(rB, tB, hB2, tB2);
        itA = itA2; tA = tA2; hA = hA2; itB = itB2; tB = tB2; hB = hB2;
    }
#undef CV_LOAD
#undef CV_PROCESS
}
__device__ __forceinline__ void p0_prologue(Frame& F, const Args& A, bool nostore = false) {
    const int gw = F.vcu * 8 + F.wave, NGW = F.G * 8, lane = F.lane;
    convert_items(F, A, P0_LATE_ITEMS, P0_EARLY_ITEMS, gw, NGW, (LAS float*)(F.lds + (F.wave < 7 ? F.wave * 16640 : 145280)), nostore);
    if (nostore) return;
    bf16_t* XN = (bf16_t*)(F.ws + WS_XN);
    {
        const f32x4* gr = (const f32x4*)A.in[2] + lane;
        for (int m0 = gw; m0 < T; m0 += 4 * NGW) {
            f32x4 v[4][4]; float s[4];
#pragma unroll
            for (int rr = 0; rr < 4; ++rr) { const int m = m0 + rr * NGW; const f32x4* xr = (const f32x4*)(A.in[0] + (size_t)(m < T ? m : m0) * D) + lane;
#pragma unroll
                for (int q = 0; q < 4; ++q) v[rr][q] = xr[64 * q]; }
#pragma unroll
            for (int rr = 0; rr < 4; ++rr) { float t = 0.f;
#pragma unroll
                for (int q = 0; q < 4; ++q) t += (v[rr][q].x * v[rr][q].x + v[rr][q].y * v[rr][q].y) + (v[rr][q].z * v[rr][q].z + v[rr][q].w * v[rr][q].w);
                s[rr] = 1.f / sqrtf(wave_sum(t) * (1.f / D) + EPS); }
#pragma unroll
            for (int rr = 0; rr < 4; ++rr) { const int m = m0 + rr * NGW; if (m < T) { unsigned long long* o8 = (unsigned long long*)(XN + (size_t)m * D) + lane;
#pragma unroll
                for (int q = 0; q < 4; ++q) { const f32x4 gg = gr[64 * q]; const f32x4 w = v[rr][q] * s[rr] * gg;
                    o8[64 * q] = (unsigned long long)cvt_pk_bf16(w.x, w.y) | ((unsigned long long)cvt_pk_bf16(w.z, w.w) << 32); } } }
        }
    }
    bf16_t* PB = (bf16_t*)(F.ws + WS_PB);
    for (int m0 = gw; m0 < T; m0 += 8 * NGW) { f32x4 v[8];
#pragma unroll
        for (int rr = 0; rr < 8; ++rr) { const int m = m0 + rr * NGW; v[rr] = ((const f32x4*)(A.in[1] + (size_t)(m < T ? m : m0) * PLE))[lane]; }
#pragma unroll
        for (int rr = 0; rr < 8; ++rr) { const int m = m0 + rr * NGW; if (m < T) ((unsigned long long*)(PB + (size_t)m * PLE))[lane] = (unsigned long long)cvt_pk_bf16(v[rr].x, v[rr].y) | ((unsigned long long)cvt_pk_bf16(v[rr].z, v[rr].w) << 32); } }
    { float* BTI = (float*)(F.ws + WS_BTILE); const int gt = F.vcu * 512 + F.tid, NGT = F.G * 512;
      for (int i = gt; i < 24 * 5120; i += NGT) { const int key = i / 5120, idx = i % 5120, br = key >> 3, h = key & 7, jt = idx >> 10, rr = (idx >> 6) & 15, ln = idx & 63; const int dil = br == 0 ? 1 : (br == 1 ? 4 : 16);
          const int rel = 128 - 32 * jt + (ln & 31) - crow(rr, ln >> 5);
          BTI[(size_t)key * 6144 + ((((jt * 4 + (rr >> 2)) * 64 + ln) << 2) + (rr & 3))] = (rel >= 0 && rel <= 128) ? A.in[6][t5_bucket(rel * dil) * 8 + h] * LOG2E : -3.0e38f; } }
    { bf16_t* RT = (bf16_t*)(F.ws + WS_RTAB); const int gt = F.vcu * 512 + F.tid, NGT = F.G * 512;
      for (int i = gt; i < 32 * 1024; i += NGT) { const int k = i >> 5, e = i & 31; const float v = A.in[8][k] * A.in[9][i];
          const unsigned h0 = f2bf(v); const float r1 = v - __uint_as_float(h0 << 16); const unsigned h1 = f2bf(r1); const float r2 = r1 - __uint_as_float(h1 << 16); const unsigned h2 = f2bf(r2);
          RT[(size_t)(0 * 32 + e) * 1024 + k] = (bf16_t)h0; RT[(size_t)(1 * 32 + e) * 1024 + k] = (bf16_t)h1; RT[(size_t)(2 * 32 + e) * 1024 + k] = (bf16_t)h2; } }
}

__device__ __forceinline__ int fK(int row) { return (row >> 1) & 7; }
__device__ __forceinline__ int fV(int row) { return ((row >> 1) & 1) << 2; }
__device__ __forceinline__ s16x4 tr_read(LAS const unsigned char* p) { typedef short v4i16_t __attribute__((ext_vector_type(4)));
    return __builtin_bit_cast(s16x4, __builtin_amdgcn_ds_read_tr16_b64_v4i16((LAS v4i16_t*)p)); }
template <int MODE = 0>
__device__ __forceinline__ void attn_phase(Frame& F, const Args& A) {
    const int lane = F.lane, w = F.wave, r32 = lane & 31, hi = lane >> 5;
    const bf16_t* QB = (const bf16_t*)(F.ws + WS_UQKV) + (size_t)1 * T * 512; const bf16_t* KB = QB + (size_t)T * 512; const bf16_t* VB = KB + (size_t)T * 512;
    bf16_t* OB = (bf16_t*)(F.ws + (MODE ? WS_X1 : WS_OB)); float* LSE = (float*)(F.ws + (MODE ? WS_X2 : WS_LSE)); const float* BTI = (const float*)(F.ws + WS_BTILE);
#define ATT_TOK(t_) (MODE == 2 ? ((t_) & 255) : (t_))
    LAS unsigned char* Kl = F.lds; LAS unsigned char* Vl = F.lds + 49152; LAS unsigned char* Ql = F.lds + 98304;
    LAS f32x4* btile = (LAS f32x4*)(F.lds + 133120);
    constexpr int NITEM = 4 * 8 * 3 * 16;
    const int ipc = (NITEM + F.G - 1) / F.G;
    const int it0 = F.vcu * ipc, it1 = (it0 + ipc < NITEM) ? it0 + ipc : NITEM;
    const bool mix6 = (F.G == 256);
#define ATT_ITEM(i_) (mix6 ? (F.vcu >> 3) * 48 + (F.vcu & 7) + 8 * ((i_) - it0) : (i_))
#define ATT_DECODE(it_) const int bh_ = (it_) / 48, sub_ = (it_) % 48, br = sub_ / 16, q16_ = sub_ % 16, b = bh_ >> 3, h = bh_ & 7, dsh = br * 2, d = 1 << dsh, r = q16_ >> (4 - dsh), m = q16_ & ((16 >> dsh) - 1); \
        const int lbase = 256 * m - 128; const size_t rowb = (size_t)b * S;
#define ATT_ISSUE_KQ(it_, TILE_) do { ATT_DECODE(it_) \
        if (TILE_) { _Pragma("unroll") for (int pi = 0; pi < 3; ++pi) { const int piece = w + 8 * pi; \
            __builtin_amdgcn_global_load_lds((const unsigned*)(BTI + (size_t)(br * 8 + h) * 6144 + piece * 256 + lane * 4), (LAS unsigned*)((LAS unsigned char*)btile + piece * 1024), 16, 0, 0); } } \
        _Pragma("unroll") for (int pi = 0; pi < 6; ++pi) { const int piece = w + 8 * pi, row = piece * 8 + (lane >> 3), cp = lane & 7; int lp = lbase + row; lp = lp < 0 ? 0 : lp; \
            const size_t tok = rowb + (size_t)lp * d + r; \
            __builtin_amdgcn_global_load_lds((const unsigned*)(KB + ATT_TOK(tok) * 512 + h * 64 + ((cp ^ fK(row)) << 3)), (LAS unsigned*)(Kl + piece * 1024), 16, 0, 0); } \
        _Pragma("unroll") for (int pi = 0; pi < 4; ++pi) { const int piece = w + 8 * pi, row = piece * 8 + (lane >> 3), cp = lane & 7; \
            const size_t tok = rowb + (size_t)(256 * m + row) * d + r; \
            __builtin_amdgcn_global_load_lds((const unsigned*)(QB + ATT_TOK(tok) * 512 + h * 64 + ((cp ^ fK(row)) << 3)), (LAS unsigned*)(Ql + piece * 1024), 16, 0, 0); } } while (0)
#define ATT_ISSUE_V(it_) do { ATT_DECODE(it_) \
        _Pragma("unroll") for (int pi = 0; pi < 6; ++pi) { const int piece = w + 8 * pi, row = piece * 8 + (lane >> 3), cp = lane & 7; int lp = lbase + row; lp = lp < 0 ? 0 : lp; \
            const size_t tok = rowb + (size_t)lp * d + r; \
            __builtin_amdgcn_global_load_lds((const unsigned*)(VB + ATT_TOK(tok) * 512 + h * 64 + ((cp ^ fV(row)) << 3)), (LAS unsigned*)(Vl + piece * 1024), 16, 0, 0); } } while (0)
#define ATT_KEY(it_) (((it_) / 48) & 7) + 8 * (((it_) % 48) / 16)
    if (it0 < it1) { ATT_ISSUE_KQ(ATT_ITEM(it0), true); ATT_ISSUE_V(ATT_ITEM(it0)); }
    for (int it = it0; it < it1; ++it) {
        ATT_DECODE(ATT_ITEM(it))
        const bool has_next = it + 1 < it1;
        asm volatile("s_waitcnt vmcnt(6)" ::: "memory"); __builtin_amdgcn_s_barrier(); asm volatile("" ::: "memory");
        int r32v = r32, hiv = hi; asm volatile("" : "+v"(r32v), "+v"(hiv));
        const int qrow = 32 * w + r32v;
        bf16x8 qf[4];
#pragma unroll
        for (int d0 = 0; d0 < 4; ++d0) qf[d0] = *(const LAS bf16x8*)(Ql + qrow * 128 + (((2 * d0 + hiv) ^ fK(qrow)) << 4));
        const size_t qtok = rowb + (size_t)(256 * m + qrow) * d + r;
        f32x16 p[5];
        float mx = -3.0e38f;
#pragma unroll
        for (int jt = 0; jt < 5; ++jt) {
            if (MODE == 5 || (m == 0 && w + jt < 4)) {
#pragma unroll
                for (int rr = 0; rr < 16; ++rr) p[jt][rr] = -3.0e38f;
            } else {
                const int krow = 32 * w + 32 * jt + r32v;
                f32x16 acc;
#pragma unroll
                for (int g4 = 0; g4 < 4; ++g4) { const f32x4 bv = btile[(jt * 4 + g4) * 64 + lane]; acc[4 * g4 + 0] = bv[0]; acc[4 * g4 + 1] = bv[1]; acc[4 * g4 + 2] = bv[2]; acc[4 * g4 + 3] = bv[3]; }
#pragma unroll
                for (int d0 = 0; d0 < 4; ++d0) { const bf16x8 kf = *(const LAS bf16x8*)(Kl + krow * 128 + (((2 * d0 + hiv) ^ fK(krow)) << 4));
                    acc = __builtin_amdgcn_mfma_f32_32x32x16_bf16(kf, qf[d0], acc, 0, 0, 0); }
#pragma unroll
                for (int rr = 0; rr < 16; ++rr) mx = fmaxf(mx, acc[rr]);
                p[jt] = acc;
            }
            __builtin_amdgcn_sched_barrier(0);
        }
        asm volatile("s_waitcnt lgkmcnt(0)" ::: "memory"); __builtin_amdgcn_s_barrier(); asm volatile("" ::: "memory");
        const bool nt_ = has_next && ATT_KEY(ATT_ITEM(it + 1)) != ATT_KEY(ATT_ITEM(it));
        if (has_next) ATT_ISSUE_KQ(ATT_ITEM(it + 1), nt_);
        { const float o = __shfl_xor(mx, 32); mx = fmaxf(mx, o); }
        if (nt_) asm volatile("s_waitcnt vmcnt(13)" ::: "memory"); else if (has_next) asm volatile("s_waitcnt vmcnt(10)" ::: "memory"); else asm volatile("s_waitcnt vmcnt(0)" ::: "memory");
        __builtin_amdgcn_s_barrier(); asm volatile("" ::: "memory");
        float ls = 0.f;
        f32x16 o[2]; o[0] = (f32x16){}; o[1] = (f32x16){};
#pragma unroll
        for (int jt = 0; jt < 5; ++jt) {
            if (MODE == 4 || (m == 0 && w + jt < 4)) continue;
#pragma unroll
            for (int rr = 0; rr < 16; ++rr) { const float e = __builtin_amdgcn_exp2f(p[jt][rr] - mx); p[jt][rr] = e; ls += e; }
#pragma unroll
            for (int s = 0; s < 2; ++s) {
                u32x4 pw; pw.x = cvt_pk_bf16(p[jt][8 * s + 0], p[jt][8 * s + 1]); pw.y = cvt_pk_bf16(p[jt][8 * s + 2], p[jt][8 * s + 3]);
                pw.z = cvt_pk_bf16(p[jt][8 * s + 4], p[jt][8 * s + 5]); pw.w = cvt_pk_bf16(p[jt][8 * s + 6], p[jt][8 * s + 7]);
                const bf16x8 pf = __builtin_bit_cast(bf16x8, pw);
                const int g = lane >> 4, qq = (lane & 15) >> 2, pp = lane & 3;
                const int key0 = 32 * w + 32 * jt + 16 * s + 4 * (g >> 1);
#pragma unroll
                for (int d0 = 0; d0 < 2; ++d0) {
                    const int dcol = 32 * d0 + 16 * (g & 1) + 4 * pp;
                    const int ra = key0 + qq, rb = key0 + 8 + qq;
                    const s16x4 lo = tr_read(Vl + ra * 128 + (((dcol >> 3) ^ fV(ra)) << 4) + (dcol & 7) * 2);
                    const s16x4 hh = tr_read(Vl + rb * 128 + (((dcol >> 3) ^ fV(rb)) << 4) + (dcol & 7) * 2);
                    const bf16x8 vf = (bf16x8){lo[0], lo[1], lo[2], lo[3], hh[0], hh[1], hh[2], hh[3]};
                    o[d0] = __builtin_amdgcn_mfma_f32_32x32x16_bf16(vf, pf, o[d0], 0, 0, 0);
                }
            }
            __builtin_amdgcn_sched_barrier(0);
        }
        ls += __shfl_xor(ls, 32);
        const float inv = 1.0f / ls;
        asm volatile("s_waitcnt lgkmcnt(0)" ::: "memory"); __builtin_amdgcn_s_barrier(); asm volatile("" ::: "memory");
        {
            LAS unsigned char* st = Vl + w * 1024;
            const int q = r32, q7 = q & 7;
            LAS unsigned char* sw = st + (q >> 3) * 8192 + q7 * 128 + 8 * (hi ^ ((q >> 3) & 1));
#pragma unroll
            for (int d0 = 0; d0 < 2; ++d0)
#pragma unroll
                for (int g4 = 0; g4 < 4; ++g4) { u32x2 wv; wv.x = cvt_pk_bf16(o[d0][4 * g4 + 0] * inv, o[d0][4 * g4 + 1] * inv); wv.y = cvt_pk_bf16(o[d0][4 * g4 + 2] * inv, o[d0][4 * g4 + 3] * inv);
                    *(LAS u32x2*)(sw + (((4 * d0 + g4) ^ q7) << 4)) = wv; }
            if (hi == 0) LSE[((size_t)br * T + qtok) * 8 + h] = mx + __builtin_amdgcn_logf(ls);
            asm volatile("s_waitcnt lgkmcnt(0)" ::: "memory");
            const int rr8 = lane >> 3, c8 = lane & 7;
#pragma unroll
            for (int j = 0; j < 4; ++j) {
                u32x4 v = *(const LAS u32x4*)(st + j * 8192 + rr8 * 128 + ((c8 ^ rr8) << 4));
                if (j & 1) v = (u32x4){v.z, v.w, v.x, v.y};
                const size_t tok = rowb + (size_t)(256 * m + 32 * w + 8 * j + rr8) * d + r;
                if (MODE == 3) asm volatile("" :: "v"(v)); else *(u32x4*)(OB + ((size_t)br * T + tok) * 512 + h * 64 + c8 * 8) = v;
            }
            asm volatile("s_waitcnt lgkmcnt(0)" ::: "memory");
        }
        if (has_next) ATT_ISSUE_V(ATT_ITEM(it + 1));
    }
    asm volatile("s_waitcnt vmcnt(0)" ::: "memory"); __builtin_amdgcn_s_barrier();
#undef ATT_DECODE
#undef ATT_TOK
#undef ATT_KEY
#undef ATT_ITEM
#undef ATT_ISSUE_KQ
#undef ATT_ISSUE_V
}

template <int W>
__device__ __forceinline__ void pool_frags(const bf16_t* UB, int tok, int tin, int g, int hi, bf16x8 (&bfrag)[8]) {
    const int cnt = (tin + 1 < W) ? tin + 1 : W; const float rc = 1.0f / (float)cnt;
#pragma unroll
    for (int s = 0; s < 8; ++s) {
        const bf16_t* up = UB + (size_t)tok * 512 + g * 128 + 16 * s + 8 * hi;
        u32x4 v[W];
#pragma unroll
        for (int j = 0; j < W; ++j) v[j] = *(const u32x4*)(up - (size_t)(j < cnt ? j : 0) * 512);
        float sum[8];
#pragma unroll
        for (int i = 0; i < 4; ++i) { sum[2 * i] = bflo(v[0][i]); sum[2 * i + 1] = bfhi(v[0][i]); }
#pragma unroll
        for (int j = 1; j < W; ++j) { const float mk_ = j < cnt ? 1.0f : 0.0f;
#pragma unroll
            for (int i = 0; i < 4; ++i) { sum[2 * i] += mk_ * bflo(v[j][i]); sum[2 * i + 1] += mk_ * bfhi(v[j][i]); } }
        u32x4 pw;
#pragma unroll
        for (int i = 0; i < 4; ++i) pw[i] = cvt_pk_bf16(sum[2 * i] * rc - bflo(v[0][i]), sum[2 * i + 1] * rc - bfhi(v[0][i]));
        bfrag[s] = __builtin_bit_cast(bf16x8, pw);
    }
}
__device__ __forceinline__ void merge_pool_phase(Frame& F, const Args& A, int gw, int NGW) {
    const int lane = F.lane;
    const bf16_t* OB = (const bf16_t*)(F.ws + WS_OB); const float* LSE = (const float*)(F.ws + WS_LSE); bf16_t* MIX = (bf16_t*)(F.ws + WS_MIX);
    for (int tb = gw; tb < T; tb += 4 * NGW) {
        const int h = lane >> 3;
        float ls[4][3]; u32x4 ov[4][3];
#pragma unroll
        for (int q = 0; q < 4; ++q) { const int t = (tb + q * NGW < T) ? tb + q * NGW : tb;
#pragma unroll
            for (int br = 0; br < 3; ++br) { ls[q][br] = LSE[((size_t)br * T + t) * 8 + h]; ov[q][br] = *(const u32x4*)(OB + ((size_t)br * T + t) * 512 + lane * 8); } }
#pragma unroll
        for (int q = 0; q < 4; ++q) { const int t = tb + q * NGW; if (t < T) {
            const float mm = fmaxf(ls[q][0], fmaxf(ls[q][1], ls[q][2]));
            float w0 = __builtin_amdgcn_exp2f(ls[q][0] - mm), w1 = __builtin_amdgcn_exp2f(ls[q][1] - mm), w2 = __builtin_amdgcn_exp2f(ls[q][2] - mm);
            const float inv = 1.0f / (w0 + w1 + w2); w0 *= inv; w1 *= inv; w2 *= inv;
            u32x4 o;
#pragma unroll
            for (int i = 0; i < 4; ++i) { const float lo = w0 * bflo(ov[q][0][i]) + w1 * bflo(ov[q][1][i]) + w2 * bflo(ov[q][2][i]), hi_ = w0 * bfhi(ov[q][0][i]) + w1 * bfhi(ov[q][1][i]) + w2 * bfhi(ov[q][2][i]); o[i] = cvt_pk_bf16(lo, hi_); }
            *(u32x4*)(MIX + (size_t)t * 1024 + 512 + lane * 8) = o; } }
    }
    const bf16_t* UB = (const bf16_t*)(F.ws + WS_UQKV); const bf16_t* WPT = (const bf16_t*)(F.ws + WS_WPT); const float* pscale = A.in[5];
    const int r32 = lane & 31, hi = lane >> 5;
    for (int it = gw; it < (T / 32) * 4; it += NGW) {
        const int g = it & 3, t0 = (it >> 2) * 32, tok = t0 + r32, tin = tok & (S - 1);
        bf16x8 bfrag[8];
        if (g == 0) pool_frags<2>(UB, tok, tin, g, hi, bfrag); else if (g == 1) pool_frags<4>(UB, tok, tin, g, hi, bfrag); else if (g == 2) pool_frags<8>(UB, tok, tin, g, hi, bfrag); else pool_frags<16>(UB, tok, tin, g, hi, bfrag);
#pragma unroll
        for (int db = 0; db < 4; ++db) {
            f32x16 acc = {};
#pragma unroll
            for (int s = 0; s < 8; ++s) { const bf16x8 af = *(const bf16x8*)(WPT + ((size_t)g * 128 + 32 * db + r32) * 128 + 16 * s + 8 * hi);
                acc = __builtin_amdgcn_mfma_f32_32x32x16_bf16(af, bfrag[s], acc, 0, 0, 0); }
#pragma unroll
            for (int g4 = 0; g4 < 4; ++g4) { const int dd = g * 128 + 32 * db + 8 * g4 + 4 * hi; const f32x4 sc = *(const f32x4*)(pscale + dd);
                u32x2 wv; wv.x = cvt_pk_bf16(acc[4 * g4 + 0] * sc[0], acc[4 * g4 + 1] * sc[1]); wv.y = cvt_pk_bf16(acc[4 * g4 + 2] * sc[2], acc[4 * g4 + 3] * sc[3]);
                *(u32x2*)(MIX + (size_t)tok * 1024 + dd) = wv; }
        }
    }
}
}
namespace mk {
constexpr int CNT_STRIDE = 64;
__device__ __forceinline__ void router_phase(Frame& F, const Args& A, bool dummy = false) {
    const int lane = F.lane, w = F.wave, r32 = lane & 31, hi = lane >> 5;
    const bf16_t* X1 = (const bf16_t*)(F.ws + WS_X1); const bf16_t* RT = (const bf16_t*)(F.ws + WS_RTAB); const float* g_ffn = A.in[8]; const float* b_r = A.in[10];
    unsigned char* XN8 = (unsigned char*)(F.ws + WS_XN8); int* LIST = (int*)(F.ws + WS_LIST); u32x2* TOKINFO = (u32x2*)(F.ws + WS_TOKINFO);
    unsigned* cntg = (unsigned*)(F.ws + WS_CTL) + CW_CNT;
    if (dummy) { cntg += 32 * CNT_STRIDE; LIST = (int*)(F.ws + WS_H); TOKINFO = (u32x2*)(F.ws + WS_H + 4 * MiB); XN8 = (unsigned char*)(F.ws + WS_H + 8 * MiB); }
    LAS float* part = (LAS float*)F.lds;
    LAS float* pss = (LAS float*)(F.lds + 65536);
    LAS float* lgt = (LAS float*)(F.lds + 65536 + 2048);
    LAS float* rsd = (LAS float*)(F.lds + 65536 + 2048 + 8192);
    LAS int* lcnt = (LAS int*)(F.lds + L_GTAB);
    LAS int* sel_t = lcnt + 64;
    LAS unsigned* sel_e = (LAS unsigned*)(lcnt + 192);
    LAS float* sel_g = (LAS float*)(lcnt + 704);
    const float bias_e = b_r[(lane >> 1) & 31];
    const int my_e = (lane >> 1) & 31;
    for (int chunk = F.vcu; chunk < T / 64; chunk += F.G) {
    const int tb = chunk * 64;
    if (F.tid < 32) lcnt[F.tid] = 0;
    int li = w * 16;
    {
        f32x16 acc[2]; acc[0] = (f32x16){}; acc[1] = (f32x16){}; float ss[2] = {0.f, 0.f};
        const bf16_t* xr = X1 + (size_t)(tb + r32) * D + 128 * w + 8 * hi; const bf16_t* tr = RT + (size_t)r32 * 1024 + 128 * w + 8 * hi;
#pragma unroll
        for (int half = 0; half < 2; ++half) {
            u32x4 xv[2][4], tv[3][4];
#pragma unroll
            for (int j = 0; j < 4; ++j) {
#pragma unroll
                for (int blk = 0; blk < 2; ++blk) xv[blk][j] = *(const u32x4*)(xr + (size_t)blk * 32 * D + 64 * half + 16 * j);
#pragma unroll
                for (int tm = 0; tm < 3; ++tm) tv[tm][j] = *(const u32x4*)(tr + (size_t)tm * 32 * 1024 + 64 * half + 16 * j); }
#pragma unroll
            for (int j = 0; j < 4; ++j)
#pragma unroll
                for (int blk = 0; blk < 2; ++blk) {
#pragma unroll
                    for (int tm = 0; tm < 3; ++tm) acc[blk] = __builtin_amdgcn_mfma_f32_32x32x16_bf16(__builtin_bit_cast(bf16x8, xv[blk][j]), __builtin_bit_cast(bf16x8, tv[tm][j]), acc[blk], 0, 0, 0);
#pragma unroll
                    for (int q = 0; q < 4; ++q) { const float lo = __uint_as_float(xv[blk][j][q] << 16), hh = __uint_as_float(xv[blk][j][q] & 0xffff0000u); ss[blk] += lo * lo + hh * hh; } }
        }
#pragma unroll
        for (int blk = 0; blk < 2; ++blk) {
#pragma unroll
            for (int rr = 0; rr < 16; ++rr) part[(w * 64 + blk * 32 + crow(rr, hi)) * 32 + r32] = acc[blk][rr];
            const float t2 = ss[blk] + __shfl_xor(ss[blk], 32); if (hi == 0) pss[w * 64 + blk * 32 + r32] = t2; }
    }
    LDS_WAIT(); __syncthreads();
    {
#pragma unroll
        for (int q = 0; q < 4; ++q) { const int idx = F.tid + 512 * q; float sacc = 0.f;
#pragma unroll
            for (int ww = 0; ww < 8; ++ww) sacc += part[ww * 2048 + idx];
            lgt[idx] = sacc; }
        if (F.tid < 64) { float sacc = 0.f;
#pragma unroll
            for (int ww = 0; ww < 8; ++ww) sacc += pss[ww * 64 + F.tid];
            rsd[F.tid] = 1.f / sqrtf(sacc * (1.f / D) + EPS); }
    }
    LDS_WAIT(); __syncthreads();
    for (int it2 = 0; it2 < 4; ++it2) {
        const int la_ = w * 8 + 2 * it2, t0 = tb + la_;
        const float ra = rsd[la_], rb = rsd[la_ + 1];
#pragma unroll
        for (int row = 0; row < 2; ++row) { const float rs_ = row ? rb : ra; const bf16_t* xp = X1 + (size_t)(t0 + row) * D;
#pragma unroll
            for (int hf = 0; hf < 2; ++hf) { const u32x4 xv = *(const u32x4*)(xp + 512 * hf + 8 * lane); const f32x4 g0 = *(const f32x4*)(g_ffn + 512 * hf + 8 * lane), g1 = *(const f32x4*)(g_ffn + 512 * hf + 8 * lane + 4);
                u32x2 o; o.x = pk_fp8x4(__uint_as_float(xv.x << 16) * rs_ * g0[0], __uint_as_float(xv.x & 0xffff0000u) * rs_ * g0[1], __uint_as_float(xv.y << 16) * rs_ * g0[2], __uint_as_float(xv.y & 0xffff0000u) * rs_ * g0[3]);
                o.y = pk_fp8x4(__uint_as_float(xv.z << 16) * rs_ * g1[0], __uint_as_float(xv.z & 0xffff0000u) * rs_ * g1[1], __uint_as_float(xv.w << 16) * rs_ * g1[2], __uint_as_float(xv.w & 0xffff0000u) * rs_ * g1[3]);
                *(u32x2*)(XN8 + (size_t)(t0 + row) * D + 512 * hf + 8 * lane) = o; } }
        float la = lgt[la_ * 32 + my_e] * ra + bias_e, lb = lgt[(la_ + 1) * 32 + my_e] * rb + bias_e;
        float va_ = la, vb_ = lb; float tva[4], tvb[4]; int tia[4], tib[4];
#pragma unroll
        for (int k = 0; k < 4; ++k) {
            float bva = va_, bvb = vb_; int bia = my_e, bib = my_e;
#pragma unroll
            for (int o = 2; o < 64; o <<= 1) { const float ova = __shfl_xor(bva, o), ovb = __shfl_xor(bvb, o); const int oia = __shfl_xor(bia, o), oib = __shfl_xor(bib, o);
                if (ova > bva || (ova == bva && oia < bia)) { bva = ova; bia = oia; }
                if (ovb > bvb || (ovb == bvb && oib < bib)) { bvb = ovb; bib = oib; } }
            tva[k] = bva; tia[k] = bia; if (my_e == bia) va_ = -INFINITY;
            tvb[k] = bvb; tib[k] = bib; if (my_e == bib) vb_ = -INFINITY;
        }
#pragma unroll
        for (int row = 0; row < 2; ++row) {
            const int t = t0 + row;
            const float e1 = __expf((row ? tvb[1] : tva[1]) - (row ? tvb[0] : tva[0])), e2 = __expf((row ? tvb[2] : tva[2]) - (row ? tvb[0] : tva[0])), e3 = __expf((row ? tvb[3] : tva[3]) - (row ? tvb[0] : tva[0]));
            const float inv = 1.0f / (1.0f + e1 + e2 + e3);
            if (lane < 4) { const int e = row ? (lane == 0 ? tib[0] : (lane == 1 ? tib[1] : (lane == 2 ? tib[2] : tib[3]))) : (lane == 0 ? tia[0] : (lane == 1 ? tia[1] : (lane == 2 ? tia[2] : tia[3])));
                const float gt = (lane == 0 ? 1.0f : (lane == 1 ? e1 : (lane == 2 ? e2 : e3))) * inv;
                const int rank = __hip_atomic_fetch_add(lcnt + e, 1, __ATOMIC_RELAXED, __HIP_MEMORY_SCOPE_WORKGROUP);
                sel_e[li * 4 + lane] = (unsigned)e | ((unsigned)rank << 8); sel_g[li * 4 + lane] = gt; if (lane == 0) sel_t[li] = t; }
            ++li;
        }
    }
    const int nloc = li - F.wave * 16;
    LDS_WAIT(); __syncthreads();
    if (F.tid < 32) { const int c = lcnt[F.tid]; const unsigned base = c ? __hip_atomic_fetch_add(cntg + F.tid * CNT_STRIDE, (unsigned)c, RLX_AGENT) : 0u; lcnt[F.tid] = (int)base; }
    LDS_WAIT(); __syncthreads();
    { const int w = F.tid >> 6, r = (F.tid & 63) >> 2, k = F.tid & 3;
      if (r < nloc) { const int l2 = w * 16 + r; const unsigned ev = sel_e[l2 * 4 + k]; const int e = (int)(ev & 0xffu); const unsigned pos = (unsigned)lcnt[e] + (ev >> 8); const int t = sel_t[l2];
          LIST[(size_t)e * T + pos] = t; u32x2 ti2; ti2.x = ((unsigned)e << 16) | pos; ti2.y = __float_as_uint(sel_g[l2 * 4 + k]); TOKINFO[(size_t)t * 4 + k] = ti2; } }
    LDS_WAIT(); __syncthreads();
    }
}

__device__ __forceinline__ int moe_setup(Frame& F) {
    LAS int* Lcnt = (LAS int*)(F.lds + L_CNT); LAS int* Lbase = (LAS int*)(F.lds + L_BASE); LAS int* Ltile = (LAS int*)(F.lds + L_TILE_E);
    const unsigned* cntg = (const unsigned*)(F.ws + WS_CTL) + CW_CNT;
    if (F.tid < 64) {
        const int e = F.lane & 31; const int c = (int)__hip_atomic_load(cntg + e * CNT_STRIDE, RLX_AGENT); const int tl = (c + 255) >> 8;
        int incl = tl;
#pragma unroll
        for (int o = 1; o < 32; o <<= 1) { const int v = __shfl_up(incl, o); if ((F.lane & 31) >= o) incl += v; }
        const int excl = incl - tl;
        if (F.lane < 32) { Lcnt[e] = c; Lbase[e] = excl; if (e == 31) Lbase[32] = incl; for (int i = 0; i < tl; ++i) Ltile[excl + i] = e; }
    }
    LDS_WAIT(); __syncthreads();
    return __builtin_amdgcn_readfirstlane(Lbase[32]);
}
__device__ __forceinline__ void moe_gather_table(Frame& F, const Order& S) {
    LAS int* Lcnt = (LAS int*)(F.lds + L_CNT); LAS int* Lbase = (LAS int*)(F.lds + L_BASE); LAS int* Ltile = (LAS int*)(F.lds + L_TILE_E); LAS int* gt = (LAS int*)(F.lds + L_GTAB);
    const int* LIST = (const int*)(F.ws + WS_LIST);
    if (F.tid < 256) {
        int tokv[MAXU];
#pragma unroll
        for (int i = 0; i < MAXU; ++i) { Unit u; tokv[i] = 0;
            if (S.next(i, u)) { const int e = Ltile[u.pm]; const int idx = (u.pm - Lbase[e]) * 256 + F.tid; if (idx < Lcnt[e]) tokv[i] = LIST[(size_t)e * T + idx]; } }
#pragma unroll
        for (int i = 0; i < MAXU; ++i) gt[i * 256 + F.tid] = tokv[i] * 1024;
    }
    LDS_WAIT(); __syncthreads();
}

__device__ __forceinline__ void combine_phase(Frame& F, const Args& A) {
    const int lane = F.lane, gw = F.vcu * 8 + F.wave, NGW = F.G * 8;
    const bf16_t* X1 = (const bf16_t*)(F.ws + WS_X1); bf16_t* X2 = (bf16_t*)(F.ws + WS_X2); const unsigned char* Y = (const unsigned char*)(F.ws + WS_Y); unsigned char* XN8 = (unsigned char*)(F.ws + WS_XN8);
    const u32x2* TOKINFO = (const u32x2*)(F.ws + WS_TOKINFO); const float* g_ple = A.in[15];
    LAS int* Lbase = (LAS int*)(F.lds + L_BASE);
    for (int t0 = gw; t0 < T; t0 += 2 * NGW) {
        const int t1 = (t0 + NGW < T) ? t0 + NGW : t0; const bool two = t0 + NGW < T;
        u32x2 ti[2][4];
#pragma unroll
        for (int k = 0; k < 4; ++k) { ti[0][k] = TOKINFO[(size_t)t0 * 4 + k]; ti[1][k] = TOKINFO[(size_t)t1 * 4 + k]; }
        f32x4 v[2][4];
#pragma unroll
        for (int j = 0; j < 4; ++j) { const u32x2 a = ((const u32x2*)(X1 + (size_t)t0 * D))[lane + 64 * j], b = ((const u32x2*)(X1 + (size_t)t1 * D))[lane + 64 * j];
            v[0][j] = (f32x4){__uint_as_float(a.x << 16), __uint_as_float(a.x & 0xffff0000u), __uint_as_float(a.y << 16), __uint_as_float(a.y & 0xffff0000u)};
            v[1][j] = (f32x4){__uint_as_float(b.x << 16), __uint_as_float(b.x & 0xffff0000u), __uint_as_float(b.y << 16), __uint_as_float(b.y & 0xffff0000u)}; }
        unsigned yv[2][4][4];
#pragma unroll
        for (int q = 0; q < 2; ++q)
#pragma unroll
            for (int k = 0; k < 4; ++k) { const int e = (int)(ti[q][k].x >> 16), pos = (int)(ti[q][k].x & 0xffffu); const size_t row = (size_t)Lbase[e] * 256 + pos; const unsigned* yr = (const unsigned*)(Y + row * 1024);
#pragma unroll
                for (int j = 0; j < 4; ++j) yv[q][k][j] = yr[lane + 64 * j]; }
#pragma unroll
        for (int q = 0; q < 2; ++q) {
#pragma unroll
            for (int k = 0; k < 4; ++k) { const float gt = __uint_as_float(ti[q][k].y);
#pragma unroll
                for (int j = 0; j < 4; ++j) { const f32x2 lo = fp8x2_lo(yv[q][k][j]), hi = fp8x2_hi(yv[q][k][j]); v[q][j].x += gt * lo[0]; v[q][j].y += gt * lo[1]; v[q][j].z += gt * hi[0]; v[q][j].w += gt * hi[1]; } }
            if (q == 0 || two) { const int t = q ? t1 : t0;
                float s = 0.f;
                unsigned long long* x8 = (unsigned long long*)(X2 + (size_t)t * D) + lane;
#pragma unroll
                for (int j = 0; j < 4; ++j) { x8[64 * j] = (unsigned long long)cvt_pk_bf16(v[q][j].x, v[q][j].y) | ((unsigned long long)cvt_pk_bf16(v[q][j].z, v[q][j].w) << 32); s += (v[q][j].x * v[q][j].x + v[q][j].y * v[q][j].y) + (v[q][j].z * v[q][j].z + v[q][j].w * v[q][j].w); }
                const float rstd = 1.f / sqrtf(wave_sum(s) * (1.f / D) + EPS);
                unsigned* o4 = (unsigned*)(XN8 + (size_t)t * D) + lane;
#pragma unroll
                for (int j = 0; j < 4; ++j) { const f32x4 gg = ((const f32x4*)g_ple)[lane + 64 * j];
                    o4[64 * j] = pk_fp8x4(v[q][j].x * rstd * gg.x, v[q][j].y * rstd * gg.y, v[q][j].z * rstd * gg.z, v[q][j].w * rstd * gg.w); } }
        }
    }
}
__device__ __forceinline__ void ple_fused_phase(Frame& F, const Args& A) {
    typedef int v4i32_t __attribute__((ext_vector_type(4)));
    const int lane = F.lane, w = F.wave;
    const bf16_t* X1 = (const bf16_t*)(F.ws + WS_X1); bf16_t* X2 = (bf16_t*)(F.ws + WS_X2); const unsigned char* Y = (const unsigned char*)(F.ws + WS_Y);
    const u32x2* TOKINFO = (const u32x2*)(F.ws + WS_TOKINFO); const float* g_ple = A.in[15]; const bf16_t* PP = (const bf16_t*)(F.ws + WS_PPB);
    const unsigned char* W8 = (const unsigned char*)(F.ws + WS_WT_PG); const float* gfin = A.in[18];
    LAS int* Lbase = (LAS int*)(F.lds + L_BASE);
    LAS unsigned char* AI = F.lds;
    LAS float* P = (LAS float*)(F.lds + 65536);
    LAS float* Sr = P + 512;
    for (int chunk = F.vcu; chunk < T / 64; chunk += F.G) {
        const int tb = chunk * 64;
        for (int it = 0; it < 4; ++it) {
            const int t0 = tb + 8 * w + 2 * it, t1 = t0 + 1;
            u32x2 ti[2][4];
#pragma unroll
            for (int k = 0; k < 4; ++k) { ti[0][k] = TOKINFO[(size_t)t0 * 4 + k]; ti[1][k] = TOKINFO[(size_t)t1 * 4 + k]; }
            f32x4 v[2][4];
#pragma unroll
            for (int j = 0; j < 4; ++j) { const u32x2 a = ((const u32x2*)(X1 + (size_t)t0 * D))[lane + 64 * j], b = ((const u32x2*)(X1 + (size_t)t1 * D))[lane + 64 * j];
                v[0][j] = (f32x4){bflo(a.x), bfhi(a.x), bflo(a.y), bfhi(a.y)}; v[1][j] = (f32x4){bflo(b.x), bfhi(b.x), bflo(b.y), bfhi(b.y)}; }
            unsigned yv[2][4][4];
#pragma unroll
            for (int q = 0; q < 2; ++q)
#pragma unroll
                for (int k = 0; k < 4; ++k) { const int e = (int)(ti[q][k].x >> 16), pos = (int)(ti[q][k].x & 0xffffu); const size_t row = (size_t)Lbase[e] * 256 + pos; const unsigned* yr = (const unsigned*)(Y + row * 1024);
#pragma unroll
                    for (int j = 0; j < 4; ++j) yv[q][k][j] = yr[lane + 64 * j]; }
#pragma unroll
            for (int q = 0; q < 2; ++q) {
#pragma unroll
                for (int k = 0; k < 4; ++k) { const float gt = __uint_as_float(ti[q][k].y);
#pragma unroll
                    for (int j = 0; j < 4; ++j) { const f32x2 lo = fp8x2_lo(yv[q][k][j]), hi = fp8x2_hi(yv[q][k][j]); v[q][j].x += gt * lo[0]; v[q][j].y += gt * lo[1]; v[q][j].z += gt * hi[0]; v[q][j].w += gt * hi[1]; } }
                const int t = q ? t1 : t0, rl = t - tb;
                float s = 0.f;
                unsigned long long* x8 = (unsigned long long*)(X2 + (size_t)t * D) + lane;
#pragma unroll
                for (int j = 0; j < 4; ++j) { x8[64 * j] = (unsigned long long)cvt_pk_bf16(v[q][j].x, v[q][j].y) | ((unsigned long long)cvt_pk_bf16(v[q][j].z, v[q][j].w) << 32); s += (v[q][j].x * v[q][j].x + v[q][j].y * v[q][j].y) + (v[q][j].z * v[q][j].z + v[q][j].w * v[q][j].w); }
                const float rstd = 1.f / sqrtf(wave_sum(s) * (1.f / D) + EPS);
#pragma unroll
                for (int j = 0; j < 4; ++j) { const f32x4 gg = ((const f32x4*)g_ple)[lane + 64 * j];
                    *(LAS unsigned*)(AI + rl * 1024 + ((((lane >> 2) + 16 * j) ^ (rl & 7)) << 4) + 4 * (lane & 3)) = pk_fp8x4(v[q][j].x * rstd * gg.x, v[q][j].y * rstd * gg.y, v[q][j].z * rstd * gg.z, v[q][j].w * rstd * gg.w); }
            }
        }
        asm volatile("s_waitcnt vmcnt(0) lgkmcnt(0)" ::: "memory"); __syncthreads();
        f32x4 acc[4][8];
#pragma unroll
        for (int m = 0; m < 4; ++m)
#pragma unroll
            for (int j = 0; j < 8; ++j) acc[m][j] = (f32x4){0.f, 0.f, 0.f, 0.f};
        int lg = lane; asm volatile("" : "+v"(lg)); const int fr = lg & 15, fq = lg >> 4;
        const unsigned char* wb = W8 + (size_t)(128 * w) * 1024;
        unsigned wvo = (unsigned)(fr * 1024 + 16 * fq); asm volatile("" : "+s"(wb), "+v"(wvo));
        unsigned ao0 = (unsigned)(fr * 1024 + ((fq ^ (fr & 7)) << 4)), ao1 = (unsigned)(fr * 1024 + (((fq + 4) ^ (fr & 7)) << 4)); asm volatile("" : "+v"(ao0), "+v"(ao1));
        v8i32 bq[3][2], af[4];
#define PF_LOADB(S_, BUF) do { const int kt_ = (S_) >> 2, j0_ = ((S_) & 3) * 2; _Pragma("unroll") for (int jj = 0; jj < 2; ++jj) { const unsigned char* p_ = wb + (size_t)(16 * (j0_ + jj)) * 1024 + 128 * kt_; \
            const v4i32_t lo_ = *(const v4i32_t*)(p_ + wvo), hi_ = *(const v4i32_t*)(p_ + 64 + wvo); bq[BUF][jj] = __builtin_shufflevector(lo_, hi_, 0, 1, 2, 3, 4, 5, 6, 7); } } while (0)
        PF_LOADB(0, 0); PF_LOADB(1, 1);
#pragma unroll
        for (int st = 0; st < 32; ++st) {
            if (st + 2 < 32) PF_LOADB(st + 2, (st + 2) % 3);
            asm volatile("" ::: "memory"); __builtin_amdgcn_sched_barrier(0);
            if ((st & 3) == 0) { const int kt = st >> 2;
#pragma unroll
                for (int m = 0; m < 4; ++m) { const v4i32_t lo_ = *(const LAS v4i32_t*)(AI + ao0 + (m * 16384 + 128 * kt)), hi_ = *(const LAS v4i32_t*)(AI + ao1 + (m * 16384 + 128 * kt));
                    af[m] = __builtin_shufflevector(lo_, hi_, 0, 1, 2, 3, 4, 5, 6, 7); } }
#pragma unroll
            for (int jj = 0; jj < 2; ++jj)
#pragma unroll
                for (int m = 0; m < 4; ++m) asm volatile("v_mfma_f32_16x16x128_f8f6f4 %0, %1, %2, %0" : "+v"(acc[m][(st & 3) * 2 + jj]) : "v"(bq[st % 3][jj]), "v"(af[m]));
            asm volatile("" ::: "memory"); __builtin_amdgcn_sched_barrier(0);
        }
#undef PF_LOADB
        asm volatile("s_nop 15\n\ts_nop 15" ::: "memory");
        int le = lane; asm volatile("" : "+v"(le)); const int er = le & 15, eq = le >> 4;
        unsigned evo = (unsigned)(er * D + 4 * eq); asm volatile("" : "+v"(evo));
#pragma unroll
        for (int m = 0; m < 4; ++m) { const int row = 16 * m + er; const size_t ub = (size_t)(tb + 16 * m) * D + 128 * w; float ss = 0.f;
#pragma unroll
            for (int j = 0; j < 8; ++j) { const u32x2 xw = *(const u32x2*)(X2 + ub + 16 * j + evo); const u32x2 pw = *(const u32x2*)(PP + ub + 16 * j + evo); const f32x4 a = acc[m][j]; f32x4 r;
                r[0] = bflo(xw.x) + bflo(pw.x) * sigmoidf_fast(a[0] * WSCALE_INV); r[1] = bfhi(xw.x) + bfhi(pw.x) * sigmoidf_fast(a[1] * WSCALE_INV);
                r[2] = bflo(xw.y) + bflo(pw.y) * sigmoidf_fast(a[2] * WSCALE_INV); r[3] = bfhi(xw.y) + bfhi(pw.y) * sigmoidf_fast(a[3] * WSCALE_INV);
                ss += (r[0] * r[0] + r[1] * r[1]) + (r[2] * r[2] + r[3] * r[3]); acc[m][j] = r; }
            ss += __shfl_xor(ss, 16); ss += __shfl_xor(ss, 32);
            if (eq == 0) P[row * 8 + w] = ss;
            asm volatile("" ::: "memory"); }
        LDS_WAIT(); __syncthreads();
        if (F.tid < 64) { float q = 0.f;
#pragma unroll
            for (int ww = 0; ww < 8; ++ww) q += P[F.tid * 8 + ww];
            Sr[F.tid] = 1.0f / sqrtf(q * (1.0f / D) + EPS); }
        LDS_WAIT(); __syncthreads();
#pragma unroll
        for (int j = 0; j < 8; ++j) { const f32x4 gv = *(const f32x4*)(gfin + 128 * w + 16 * j + 4 * eq);
#pragma unroll
            for (int m = 0; m < 4; ++m) { const int row = 16 * m + er; *(f32x4*)(F.out + ((size_t)(tb + 16 * m) * D + 128 * w + 16 * j) + evo) = acc[m][j] * Sr[row] * gv; } }
        LDS_WAIT(); __syncthreads();
    }
}
__device__ __forceinline__ void final_phase(Frame& F, const Args& A) {
    const int lane = F.lane, gw = F.vcu * 8 + F.wave, NGW = F.G * 8;
    const float* rowss = (const float*)(F.ws + WS_ROWSS); const float* g_final = A.in[18];
    for (int t = gw; t < T; t += NGW) {
        const float rstd = 1.f / sqrtf(rowss[t] * (1.f / D) + EPS);
#pragma unroll
        for (int j = 0; j < 4; ++j) { f32x4* p = (f32x4*)(F.out + (size_t)t * D) + lane + 64 * j; const f32x4 gg = ((const f32x4*)g_final)[lane + 64 * j]; f32x4 v = *p; v = v * rstd * gg; *p = v; }
    }
}

#ifndef DUP
#define DUP (-1)
#endif
__global__ void __launch_bounds__(512, 2) mega_fwd(Args args) {
    extern __shared__ __attribute__((aligned(16))) unsigned char lds_raw[];
    Frame F;
    F.lds = (LAS unsigned char*)lds_raw;
    F.tid = threadIdx.x; F.lane = F.tid & 63; F.wave = __builtin_amdgcn_readfirstlane(F.tid >> 6);
    F.G = gridDim.x; { const int bx = blockIdx.x; F.vcu = (F.G % 8 == 0) ? (bx % 8) * (F.G / 8) + bx / 8 : bx; }
    F.ws = args.ws; F.out = args.out;
    volatile LAS unsigned* MISC = (volatile LAS unsigned*)(F.lds + L_MISC);
    if (F.tid < 64) MISC[F.tid] = 0u;
    __syncthreads();
    unsigned* ctl = (unsigned*)(F.ws + WS_CTL);
    XcdBarrier bar = xcd_barrier_post(ctl + CW_BAR, MISC + 8);
    const int lo = args.ph_lo, hi = args.ph_hi;
#define IN(k) (lo <= (k) && (k) < hi)
#if defined(PROBE_A)
    unsigned long long* ts_ = (unsigned long long*)(F.ws + WS_CTL + 256 * 1024);
#define STAMP(i) do { if (blockIdx.x == 0 && F.tid == 0) ts_[i] = __builtin_amdgcn_s_memrealtime(); } while (0)
#else
    unsigned long long* ts_ = nullptr;
#define STAMP(i) do { } while (0)
#endif
    STAMP(0);
#define SEAM(k) do { if (IN(k) && IN((k) + 1)) { xcd_barrier(bar); if (DUP == 20) xcd_barrier(bar); } STAMP((k) + 1); } while (0)
    LAS unsigned char* ring = F.lds;
#ifndef ONLYP
#define ONLYP (-1)
#endif
#define RUN(k, BODY) do { if constexpr (ONLYP < 0 || ONLYP == (k)) { if (IN(k)) { BODY if (DUP == (k)) { BODY } } } } while (0)
#define P1_BODY \
        { Gemm g{(const bf16_t*)(F.ws + WS_XN), (const bf16_t*)(F.ws + WS_WT_IN), 1024}; Order S; S.init(T / 256, 2048 / 256, F.G, (int)blockIdx.x, nullptr); \
          EpiUQKV E{(bf16_t*)(F.ws + WS_UQKV), (size_t)T * 512}; gemm_phase<EpiUQKV, false>(ring, g, S, E, nullptr); } \
        { Gemm g{(const bf16_t*)(F.ws + WS_PB), (const bf16_t*)(F.ws + WS_WT_PP), 256}; Order S; S.init(T / 256, 1024 / 256, F.G, (int)blockIdx.x, nullptr); \
          EpiBf16 E{(bf16_t*)(F.ws + WS_PPB), 1024}; gemm_phase<EpiBf16, false>(ring, g, S, E, nullptr); }
#define P4_BODY \
        { Gemm g{(const bf16_t*)(F.ws + WS_MIX), (const bf16_t*)(F.ws + WS_WT_OUT), 1024}; Order S; S.init(T / 256, 1024 / 256, F.G, (int)blockIdx.x, nullptr); \
          EpiResBf16 E{args.in[0], (bf16_t*)(F.ws + WS_X1)}; gemm_phase<EpiResBf16, false>(ring, g, S, E, nullptr); }
#define P6_BODY \
        { Gemm g{(const bf16_t*)(F.ws + WS_XN8), (const bf16_t*)(F.ws + WS_WT_GU), 512}; Order S; S.init(ntiles, 8, F.G, (int)blockIdx.x, Ltile); \
          moe_gather_table(F, S); \
          EpiSwiGLU E{(unsigned char*)(F.ws + WS_H), args.in[12]}; gemm_phase<EpiSwiGLU, true, true>(ring, g, S, E, (const LAS int*)(F.lds + L_GTAB)); }
#define P7_BODY \
        { Gemm g{(const bf16_t*)(F.ws + WS_H), (const bf16_t*)(F.ws + WS_WT_DN), 512}; Order S; S.init(ntiles, 4, F.G, (int)blockIdx.x, Ltile); \
          EpiDown E{(unsigned char*)(F.ws + WS_Y), args.in[14]}; gemm_phase<EpiDown, false, true>(ring, g, S, E, nullptr); }
#define P9_BODY \
        { Gemm g{(const bf16_t*)(F.ws + WS_XN8), (const bf16_t*)(F.ws + WS_WT_PG), 512}; Order S; S.init(T / 256, 1024 / 256, F.G, (int)blockIdx.x, nullptr); \
          if (F.G == 256) { EpiPleNorm E{(const bf16_t*)(F.ws + WS_X2), (const bf16_t*)(F.ws + WS_PPB), F.out, args.in[18], (float*)(F.ws + WS_XBUF), (unsigned*)(F.ws + WS_CTL) + CW_PANEL, (unsigned*)(F.ws + WS_CTL) + CW_TMO, ts_}; \
              gemm_phase<EpiPleNorm, false, true>(ring, g, S, E, nullptr); } \
          else { EpiPle E{(const bf16_t*)(F.ws + WS_X2), (const bf16_t*)(F.ws + WS_PPB), F.out, (float*)(F.ws + WS_ROWSS)}; gemm_phase<EpiPle, false, true>(ring, g, S, E, nullptr); \
              xcd_barrier(bar); final_phase(F, args); } }
    RUN(0, p0_prologue(F, args););
    if (DUP == 101 && IN(0)) p0_probe<2>(F, args);
    SEAM(0);
    RUN(1, P1_BODY);
    SEAM(1);
    RUN(2, attn_phase(F, args);); if (DUP == 21 && IN(2)) attn_phase<1>(F, args); if (DUP == 22 && IN(2)) attn_phase<2>(F, args); if (DUP == 23 && IN(2)) attn_phase<3>(F, args); if (DUP == 24 && IN(2)) attn_phase<4>(F, args); if (DUP == 25 && IN(2)) attn_phase<5>(F, args);
    SEAM(2);
#ifndef P3_MODE
#define P3_MODE 0
#endif
#define P3_BODY \
        { if (P3_MODE == 0) { if (F.wave < 4) merge_pool_phase(F, args, F.vcu * 4 + F.wave, F.G * 4); \
              else convert_items(F, args, 0, P0_LATE_ITEMS, F.vcu * 4 + (F.wave - 4), F.G * 4, (LAS float*)(F.lds + (F.wave - 4) * 16640)); } \
          else if (P3_MODE == 1) { convert_items(F, args, 0, P0_LATE_ITEMS, F.vcu * 8 + F.wave, F.G * 8, (LAS float*)(F.lds + (F.wave < 7 ? F.wave * 16640 : 145280))); \
              merge_pool_phase(F, args, F.vcu * 8 + F.wave, F.G * 8); } \
          else { if (F.wave >= 6) merge_pool_phase(F, args, F.vcu * 2 + (F.wave - 6), F.G * 2); \
              else convert_items(F, args, 0, P0_LATE_ITEMS, F.vcu * 6 + F.wave, F.G * 6, (LAS float*)(F.lds + F.wave * 16640)); } }
    RUN(3, P3_BODY);
    SEAM(3);
    RUN(4, P4_BODY);
    SEAM(4);
    if (IN(5)) { router_phase(F, args); if (DUP == 5) router_phase(F, args, true); }
    SEAM(5);
    if (IN(6) || IN(7) || IN(8)) {
        const int ntiles = moe_setup(F);
        const LAS int* Ltile = (const LAS int*)(F.lds + L_TILE_E);
        RUN(6, P6_BODY);
        SEAM(6);
        RUN(7, P7_BODY);
        SEAM(7);
        if (IN(8) || IN(9)) ple_fused_phase(F, args);
    }
#undef RUN
#undef IN
#undef SEAM
}

static int g_grid = 0;
static bool launch_phases(void* const* d_in, void* d_out, void* d_ws, size_t ws_size, hipStream_t stream, int lo, int hi) {
    if (g_grid == 0) {
        int dev = 0, cus = 0;
        if (hipGetDevice(&dev) != hipSuccess || hipDeviceGetAttribute(&cus, hipDeviceAttributeMultiprocessorCount, dev) != hipSuccess) { g_grid = -1; return false; }
        if (hipFuncSetAttribute((const void*)mega_fwd, hipFuncAttributeMaxDynamicSharedMemorySize, LDS_BYTES) != hipSuccess) { fprintf(stderr, "hipFuncSetAttribute failed\n"); g_grid = -1; return false; }
        int per_cu = 0;
        if (hipOccupancyMaxActiveBlocksPerMultiprocessor(&per_cu, (const void*)mega_fwd, 512, LDS_BYTES) != hipSuccess || per_cu < 1) { fprintf(stderr, "occupancy query: %d\n", per_cu); }
        (void)hipGetLastError();
        if (ws_size < WS_END) { fprintf(stderr, "workspace too small: %zu < %zu\n", ws_size, (size_t)WS_END); g_grid = -1; return false; }
        g_grid = cus;
    }
    if (g_grid < 0) return false;
    Args a{};
    for (int i = 0; i < 19; ++i) a.in[i] = (const float*)d_in[i];
    a.out = (float*)d_out; a.ws = (unsigned char*)d_ws; a.ph_lo = lo; a.ph_hi = hi;
    hipLaunchKernelGGL(mega_fwd, dim3(g_grid), dim3(512), LDS_BYTES, stream, a);
    return true;
}
}
extern "C" void kernel_launch(void* const* d_in, const int* in_sizes, int n_in, void* d_out, int out_size, void* d_ws, size_t ws_size, hipStream_t stream) {
    (void)in_sizes; (void)n_in; (void)out_size;
    if (hipMemsetAsync((char*)d_ws + mk::WS_CTL, 0, mk::CTL_ZERO_BYTES, stream) != hipSuccess) { fprintf(stderr, "memset failed\n"); return; }
    mk::launch_phases(d_in, d_out, d_ws, ws_size, stream, 0, 10);
}
```
